# Optimizing an MI355X kernel written in HIP

```python
import jax, jax.numpy as jnp
from jax import lax
import numpy as np

D_MODEL = 1024
BATCH = 8
SEQ = 4096
DEPTH = 1

GRID_W = 64
CTX_LEN = 256
N_HEADS_A = 8
HEAD_DIM_A = 128
WIDTH_A = N_HEADS_A * HEAD_DIM_A
QKV_CONV = 3
CHUNK = 64
WIDTH_B = 1024
N_GROUPS_B = 8
CONV_B = 3
N_DIR = 2
SPLIT_SIZES = (3 * WIDTH_A, WIDTH_A, 2 * N_DIR * N_HEADS_A, WIDTH_B, WIDTH_B, WIDTH_B, WIDTH_B, D_MODEL, D_MODEL)
IN_COLS = sum(SPLIT_SIZES)
DN_ALPHA = (2.0 * DEPTH) ** 0.25
DN_BETA = (8.0 * DEPTH) ** -0.25
LN_EPS = 1e-5
RMS_EPS = 1e-6
L2_EPS = 1e-6

kernel_name = "hybrid_gdn_shortconv_dit_block"


def _layernorm(x, gain=None, bias=None):
    xf = x.astype(jnp.float32)
    mu = jnp.mean(xf, axis=-1, keepdims=True)
    var = jnp.mean(jnp.square(xf - mu), axis=-1, keepdims=True)
    y = (xf - mu) * lax.rsqrt(var + LN_EPS)
    if gain is not None:
        y = y * gain.astype(jnp.float32) + bias.astype(jnp.float32)
    return y.astype(x.dtype)


def _conv_seq(u, w):
    k = w.shape[0]
    r = k // 2
    length = u.shape[1]
    up = jnp.pad(u, ((0, 0), (r, r), (0, 0)))
    out = up[:, 0:length] * w[0]
    for i in range(1, k):
        out = out + up[:, i:i + length] * w[i]
    return out


def _conv_latent(u, w):
    b, length, ch = u.shape
    rows = length // GRID_W
    y = _conv_seq(u.reshape(b * rows, GRID_W, ch), w)
    return y.reshape(b, length, ch)


def _split_cols(p):
    idx = [int(i) for i in np.cumsum(SPLIT_SIZES)[:-1]]
    return jnp.split(p, idx, axis=-1)


def _heads(t):
    b, length, _ = t.shape
    return t.reshape(b, length, N_HEADS_A, HEAD_DIM_A).transpose(0, 2, 1, 3)


def _l2norm(t):
    tf = t.astype(jnp.float32)
    return tf * lax.rsqrt(jnp.sum(tf * tf, axis=-1, keepdims=True) + L2_EPS)


def _gdn_inputs(qkv, ab, conv_w, conv_fn):
    qkv = jax.nn.silu(conv_fn(qkv, conv_w))
    q, k, v = jnp.split(qkv, 3, axis=-1)
    q = _l2norm(_heads(q)) * (HEAD_DIM_A ** -0.5)
    k = _l2norm(_heads(k))
    v = _heads(v).astype(jnp.float32)
    ab = jnp.transpose(ab.astype(jnp.float32), (0, 2, 1))
    a_logit, b_logit = jnp.split(ab, 2, axis=1)
    return q, k, v, a_logit, b_logit


def _gdn_chunked(q, k, v, g, beta, s0):
    b, h, length, dk = q.shape
    dv = v.shape[-1]
    n = length // CHUNK
    q = q.reshape(b, h, n, CHUNK, dk)
    k = k.reshape(b, h, n, CHUNK, dk)
    v = v.reshape(b, h, n, CHUNK, dv)
    g_cum = jnp.cumsum(g.reshape(b, h, n, CHUNK), axis=-1)
    beta = beta.reshape(b, h, n, CHUNK)
    tri_incl = jnp.tril(jnp.ones((CHUNK, CHUNK), dtype=bool))
    tri_strict = jnp.tril(jnp.ones((CHUNK, CHUNK), dtype=bool), k=-1)
    diff = g_cum[..., :, None] - g_cum[..., None, :]
    decay = jnp.exp(jnp.where(tri_incl, diff, -jnp.inf))
    k_beta = k * beta[..., None]
    v_beta = v * beta[..., None]
    m = jnp.where(tri_strict, jnp.einsum('bhncd,bhnsd->bhncs', k_beta, k) * decay, 0.0)
    eye = jnp.eye(CHUNK, dtype=jnp.float32)
    t_inv = lax.linalg.triangular_solve(eye + m, jnp.broadcast_to(eye, m.shape), left_side=True, lower=True)
    u = jnp.einsum('bhncs,bhnsv->bhncv', t_inv, v_beta)
    w = jnp.einsum('bhncs,bhnsd->bhncd', t_inv, k_beta * jnp.exp(g_cum)[..., None])
    qk = jnp.einsum('bhncd,bhnsd->bhncs', q, k) * decay
    q_dec = q * jnp.exp(g_cum)[..., None]
    k_dec = k * jnp.exp(g_cum[..., -1:] - g_cum)[..., None]
    chunk_decay = jnp.exp(g_cum[..., -1])

    def step(s, xs):
        qk_i, q_dec_i, k_dec_i, u_i, w_i, d_i = xs
        v_new = u_i - jnp.einsum('bhck,bhkv->bhcv', w_i, s)
        o = jnp.einsum('bhck,bhkv->bhcv', q_dec_i, s) + jnp.einsum('bhcs,bhsv->bhcv', qk_i, v_new)
        s = s * d_i[..., None, None] + jnp.einsum('bhck,bhcv->bhkv', k_dec_i, v_new)
        return s, o

    xs = tuple(jnp.moveaxis(t, 2, 0) for t in (qk, q_dec, k_dec, u, w, chunk_decay))
    s_final, o = lax.scan(step, s0, xs)
    o = jnp.moveaxis(o, 0, 2).reshape(b, h, length, dv)
    return s_final, o


def _direction_inputs(inp, a_rate_d, dtb_d, d, reverse):
    q, k, v, a_logit, b_logit = inp
    hs = slice(d * N_HEADS_A, (d + 1) * N_HEADS_A)
    g = -a_rate_d[:, None] * jax.nn.softplus(a_logit[:, hs] + dtb_d[:, None])
    beta = jax.nn.sigmoid(b_logit[:, hs])
    seqs = (q, k, v, g, beta)
    if reverse:
        seqs = tuple(jnp.flip(t, axis=2) for t in seqs)
    return seqs


def _gdn_bidir(in_c, in_x, a_log, dt_bias):
    a_rate = jnp.exp(a_log.astype(jnp.float32))
    dtb = dt_bias.astype(jnp.float32)
    b = in_x[0].shape[0]
    outs_c, outs_x = [], []
    for d in range(N_DIR):
        reverse = d == 1
        s0 = jnp.zeros((b, N_HEADS_A, HEAD_DIM_A, HEAD_DIM_A), jnp.float32)
        s_c, o_c = _gdn_chunked(*_direction_inputs(in_c, a_rate[d], dtb[d], d, reverse), s0)
        _, o_x = _gdn_chunked(*_direction_inputs(in_x, a_rate[d], dtb[d], d, reverse), s_c)
        if reverse:
            o_c = jnp.flip(o_c, axis=2)
            o_x = jnp.flip(o_x, axis=2)
        outs_c.append(o_c)
        outs_x.append(o_x)
    return outs_c[0] + outs_c[1], outs_x[0] + outs_x[1]


def _gated_rmsnorm(o, z, w):
    o = jnp.transpose(o, (0, 2, 1, 3))
    o = o * lax.rsqrt(jnp.mean(o * o, axis=-1, keepdims=True) + RMS_EPS) * w.astype(jnp.float32)
    y = o * jax.nn.silu(z.reshape(o.shape).astype(jnp.float32))
    return y.reshape(o.shape[0], o.shape[1], WIDTH_A).astype(z.dtype)


def _branch_merge(o_a, p, conv_fn, o_norm_w, conv_b_w, conv_b_b, w_a, w_b, w_out):
    _, z_a, _, x_in, b_gate, c_gate, z_b, g_a, g_b = p
    y_a = _gated_rmsnorm(o_a, z_a, o_norm_w)
    y_b = b_gate * (conv_fn(c_gate * x_in, conv_b_w) + conv_b_b) * jax.nn.silu(z_b)
    merged = jax.nn.sigmoid(g_a) * (y_a @ w_a) + jax.nn.sigmoid(g_b) * (y_b @ w_b)
    return merged @ w_out


def setup_inputs(seed: int = 0) -> dict:
    key = jax.random.key(seed)
    ks = jax.random.split(key, 20)
    f32 = jnp.float32
    nrm = lambda k, shape, s: jax.random.normal(k, shape, f32) * s
    dt = jnp.exp(jax.random.uniform(ks[9], (DEPTH, N_DIR, N_HEADS_A), f32, np.log(1e-3), np.log(1e-1)))
    return {
        "x": nrm(ks[0], (BATCH, SEQ, D_MODEL), 1.0),
        "c": nrm(ks[1], (BATCH, D_MODEL), 1.0),
        "ctx": nrm(ks[2], (BATCH, CTX_LEN, D_MODEL), 1.0),
        "c_ctx": nrm(ks[3], (D_MODEL,), 1.0),
        "w_mod": nrm(ks[4], (DEPTH, D_MODEL, 3 * D_MODEL), 0.5 * D_MODEL ** -0.5),
        "b_mod": nrm(ks[5], (DEPTH, 3 * D_MODEL), 0.01),
        "w_in": nrm(ks[6], (DEPTH, D_MODEL, IN_COLS), D_MODEL ** -0.5),
        "b_in": nrm(ks[7], (DEPTH, IN_COLS), 0.01),
        "conv_qkv_w": nrm(ks[8], (DEPTH, QKV_CONV, 3 * WIDTH_A), QKV_CONV ** -0.5),
        "a_log": jnp.log(jax.random.uniform(ks[10], (DEPTH, N_DIR, N_HEADS_A), f32, 1.0, 16.0)),
        "dt_bias": dt + jnp.log(-jnp.expm1(-dt)),
        "o_norm_w": 1.0 + nrm(ks[11], (DEPTH, HEAD_DIM_A), 0.01),
        "conv_b_w": nrm(ks[12], (DEPTH, CONV_B, WIDTH_B), CONV_B ** -0.5),
        "conv_b_b": nrm(ks[13], (DEPTH, WIDTH_B), 0.01),
        "w_a": nrm(ks[14], (DEPTH, WIDTH_A, D_MODEL), DN_BETA * WIDTH_A ** -0.5),
        "w_b": nrm(ks[15], (DEPTH, WIDTH_B, D_MODEL), DN_BETA * WIDTH_B ** -0.5),
        "w_out": nrm(ks[16], (DEPTH, D_MODEL, D_MODEL), DN_BETA * D_MODEL ** -0.5),
        "ln_g": 1.0 + nrm(ks[17], (DEPTH, D_MODEL), 0.01),
        "ln_b": nrm(ks[18], (DEPTH, D_MODEL), 0.01),
    }


def reference(x, c, ctx, c_ctx, w_mod, b_mod, w_in, b_in, conv_qkv_w, a_log, dt_bias, o_norm_w,
              conv_b_w, conv_b_b, w_a, w_b, w_out, ln_g, ln_b):
    for l in range(DEPTH):
        mod_x = jax.nn.silu(c) @ w_mod[l] + b_mod[l]
        mod_c = jax.nn.silu(c_ctx) @ w_mod[l] + b_mod[l]
        shift_x, scale_x, gate_x = jnp.split(mod_x[:, None, :], 3, axis=-1)
        shift_c, scale_c, gate_c = jnp.split(mod_c, 3, axis=-1)
        hx = _layernorm(x) * (1.0 + scale_x) + shift_x
        hc = _layernorm(ctx) * (1.0 + scale_c) + shift_c
        px = _split_cols(hx @ w_in[l] + b_in[l])
        pc = _split_cols(hc @ w_in[l] + b_in[l])
        in_x = _gdn_inputs(px[0], px[2], conv_qkv_w[l], _conv_latent)
        in_c = _gdn_inputs(pc[0], pc[2], conv_qkv_w[l], _conv_seq)
        o_a_c, o_a_x = _gdn_bidir(in_c, in_x, a_log[l], dt_bias[l])
        y_x = _branch_merge(o_a_x, px, _conv_latent, o_norm_w[l], conv_b_w[l], conv_b_b[l], w_a[l], w_b[l], w_out[l])
        if l < DEPTH - 1:
            y_c = _branch_merge(o_a_c, pc, _conv_seq, o_norm_w[l], conv_b_w[l], conv_b_b[l], w_a[l], w_b[l], w_out[l])
            ctx = _layernorm(DN_ALPHA * ctx + gate_c * y_c, ln_g[l], ln_b[l])
        x = _layernorm(DN_ALPHA * x + gate_x * y_x, ln_g[l], ln_b[l])
    return x
```

```cpp
#include <hip/hip_runtime.h>
#include <hip/hip_cooperative_groups.h>
#include <cstdio>
namespace cg = cooperative_groups;

#ifndef MK_MULTI
#define MK_MULTI 0
#endif

#define DI __device__ __forceinline__
#ifndef PROBE_DUP
#define PROBE_DUP -1
#endif
#define LAS __attribute__((address_space(3)))
typedef unsigned short bf16_t;
typedef short bf16x8 __attribute__((ext_vector_type(8)));
typedef short s16x4 __attribute__((ext_vector_type(4)));
typedef float f32x2 __attribute__((ext_vector_type(2)));
typedef float f32x4 __attribute__((ext_vector_type(4)));
typedef float f32x16 __attribute__((ext_vector_type(16)));
typedef unsigned u32x2 __attribute__((ext_vector_type(2)));
typedef unsigned u32x4 __attribute__((ext_vector_type(4)));
typedef __bf16 bf16x2_t __attribute__((ext_vector_type(2)));

constexpr int DM = 1024, NB = 8, SEQ = 4096, CTXL = 256, NH = 8;
constexpr int XR = NB * SEQ;
constexpr int CR = NB * CTXL;
constexpr int ROWS = XR + CR;
constexpr int INCOLS = 10272;
constexpr int NSLOT = 41 * 256;
constexpr int NCHUNK = 68;
constexpr int NTHR = 512;
constexpr int XCD_BAR_WORDS_C = 3456;
constexpr float DN_ALPHA = 1.189207115002721f;

constexpr size_t AL(size_t x) { return (x + 255) & ~(size_t)255; }
constexpr size_t WS_WINT = 0;
constexpr size_t WS_BIASP = AL(WS_WINT + (size_t)NSLOT * 1024 * 2);
constexpr size_t WS_WAT = AL(WS_BIASP + (size_t)NSLOT * 4);
constexpr size_t WS_WBT = AL(WS_WAT + 2097152);
constexpr size_t WS_WOT = AL(WS_WBT + 2097152);
constexpr size_t WS_MOD = AL(WS_WOT + 2097152);
constexpr size_t WS_AB = AL(WS_MOD + 9 * 3072 * 4);
constexpr size_t WS_GC = AL(WS_AB + (size_t)ROWS * 32 * 4);
constexpr size_t WS_Q = AL(WS_GC + (size_t)128 * NCHUNK * 64 * 4);
constexpr size_t WS_K = AL(WS_Q + (size_t)ROWS * 1024 * 2);
constexpr size_t WS_V = AL(WS_K + (size_t)ROWS * 1024 * 2);
constexpr size_t WS_QC = AL(WS_V + (size_t)ROWS * 1024 * 2);
constexpr size_t WS_KC = AL(WS_QC + (size_t)CR * 1024 * 2);
constexpr size_t WS_U = AL(WS_KC + (size_t)CR * 1024 * 2);
constexpr size_t WS_QKHX = AL(WS_U + (size_t)128 * NCHUNK * 16384);
constexpr size_t WS_WCTX = AL(WS_QKHX + (size_t)ROWS * 1024 * 2);
constexpr size_t WS_BAR = AL(WS_WCTX + (size_t)512 * 16384);
constexpr size_t WS_END = AL(WS_BAR + (size_t)XCD_BAR_WORDS_C * 4);

constexpr int SMEM_XB = 142336;
constexpr int P3_CW = 142352;
constexpr int P3_GC2 = P3_CW + 2 * 3 * 384 * 4;
constexpr int P3_BETA2 = P3_GC2 + 1024;
constexpr int SMEM_BYTES = P3_BETA2 + 1024;

struct Params { const float* in[19]; float* out; unsigned char* ws; int ph_lo, ph_hi; };

DI unsigned pk2(float a, float b) { f32x2 v = {a, b}; bf16x2_t r = __builtin_convertvector(v, bf16x2_t); return __builtin_bit_cast(unsigned, r); }
DI float bflo(unsigned u) { return __uint_as_float(u << 16); }
DI float bfhi(unsigned u) { return __uint_as_float(u & 0xffff0000u); }
DI float bf1(bf16_t u) { return __uint_as_float(((unsigned)u) << 16); }
DI bf16_t f2bf(float a) { return (bf16_t)(pk2(a, 0.f) & 0xffffu); }
DI float sigmoidf_(float x) { return __builtin_amdgcn_rcpf(1.f + __expf(-x)); }
DI float siluf_(float x) { return x * __builtin_amdgcn_rcpf(1.f + __expf(-x)); }
DI int crow(int i, int h) { return (i & 3) + 8 * (i >> 2) + 4 * h; }
template <class T> DI T ld_nt(const T* p) { return __builtin_nontemporal_load(p); }
template <int CTRL> DI float dppf(float v) { return __builtin_bit_cast(float, __builtin_amdgcn_update_dpp(0, __builtin_bit_cast(int, v), CTRL, 0xF, 0xF, true)); }
DI float sum32(float v) { v += dppf<0xB1>(v); v += dppf<0x4E>(v); v += dppf<0x124>(v); v += dppf<0x128>(v); v += __shfl_xor(v, 16); return v; }
DI void lbar() { asm volatile("s_waitcnt lgkmcnt(0)\n\ts_barrier" ::: "memory"); }

DI int srccol(int slot) {
    const int tile = slot >> 8, w = slot & 255;
    const int g = w >> 5, n = (w >> 4) & 1, fq = (w >> 2) & 3, j = w & 3;
    const int lc = 32 * g + 8 * fq + 4 * n + j;
    if (tile < 12) return tile * 256 + lc;
    if (tile == 12) return (w < 32) ? 4096 + lc : -1;
    if (tile < 17) return 3072 + (tile - 13) * 256 + lc;
    const int tb = tile - 17;
    if (tb < 16) {
        const int bj = w >> 7, wc2 = (w >> 5) & 3;
        const int ch = 64 * tb + 16 * wc2 + 4 * fq + j;
        return (bj == 0 ? (n ? 6176 : 4128) : (n ? 7200 : 5152)) + ch;
    }
    const int ch = (tb - 16) * 128 + 32 * ((w >> 5) & 3) + 8 * fq + 4 * n + j;
    return ((w >> 7) ? 9248 : 8224) + ch;
}
DI int plaincol(int s) { return (s & ~31) + 8 * ((s >> 2) & 3) + 4 * ((s >> 4) & 1) + (s & 3); }


#define XB_TMO      128
#define XB_XCNT(j)  (256  + 64 * (j))
#define XB_XSUB(j)  (1280 + 64 * (j))
#define XB_XGEN(j)  (2304 + 64 * (j))
#define XB_TOP      3328
#define XB_TOPGEN   3392
#define XCD_BAR_WORDS 3456
#define XB_SPIN_CAP (1u << 18)
DI unsigned xb_ld(unsigned* p) { return __hip_atomic_load(p, __ATOMIC_RELAXED, __HIP_MEMORY_SCOPE_AGENT); }
DI unsigned xb_add(unsigned* p, unsigned v) { return __hip_atomic_fetch_add(p, v, __ATOMIC_RELAXED, __HIP_MEMORY_SCOPE_AGENT); }
DI unsigned xb_xcc_id() { return (unsigned)__builtin_amdgcn_s_getreg((3 << 11) | 20) & 0xFu; }
#define XB_SPIN(cond, bar) do { unsigned _sp = 0; while (cond) { __builtin_amdgcn_s_sleep(1); \
    if ((++_sp & 255u) == 0u) { if (xb_ld(&(bar)[XB_TMO])) break; if (_sp > XB_SPIN_CAP) { atomicAdd(&(bar)[XB_TMO], 1u); break; } } } } while (0)
struct XcdBarrier { unsigned* bar; unsigned x; volatile LAS unsigned* st; };
DI XcdBarrier xcd_barrier_post(unsigned* bar, volatile LAS unsigned* st) {
    XcdBarrier b; b.bar = bar; b.x = xb_xcc_id(); b.st = st;
    if (threadIdx.x == 0) (void)xb_add(&bar[XB_XCNT(b.x)], 1u);
    return b;
}
DI void xcd_barrier_complete(unsigned* bar, unsigned x, unsigned& nloc, unsigned& nx) {
    const unsigned G = gridDim.x * gridDim.y * gridDim.z;
    unsigned sum, cnt, mine, sp = 0u;
    for (;;) {
        sum = 0u; cnt = 0u; mine = 0u;
#pragma unroll
        for (unsigned j = 0; j < 16; ++j) { const unsigned c = xb_ld(&bar[XB_XCNT(j)]); sum += c; cnt += (c > 0u) ? 1u : 0u; mine = (j == x) ? c : mine; }
        if (sum == G) break;
        __builtin_amdgcn_s_sleep(1);
        if ((++sp & 255u) == 0u) { if (xb_ld(&bar[XB_TMO])) break; if (sp > XB_SPIN_CAP) { atomicAdd(&bar[XB_TMO], 1u); break; } }
    }
    nloc = mine > 0u ? mine : 1u; nx = cnt > 0u ? cnt : 1u;
}
DI void xcd_barrier(const XcdBarrier& b) {
    asm volatile("s_waitcnt vmcnt(0)" ::: "memory");
    __syncthreads();
    if (threadIdx.x == 0) {
        unsigned* bar = b.bar;
        __builtin_amdgcn_s_waitcnt(0);
        unsigned nloc = b.st[0], nx = b.st[1];
        if (nloc == 0u) { xcd_barrier_complete(bar, b.x, nloc, nx); b.st[0] = nloc; b.st[1] = nx; }
        const unsigned old = xb_add(&bar[XB_XSUB(b.x)], 1u);
        const unsigned gen = old / nloc;
        if (old + 1u == (gen + 1u) * nloc) {
            __builtin_amdgcn_fence(__ATOMIC_RELEASE, "agent");
            asm volatile("s_waitcnt vmcnt(0)" ::: "memory");
            const unsigned og = xb_add(&bar[XB_TOP], 1u);
            const unsigned tg = og / nx;
            if (og + 1u == (tg + 1u) * nx) xb_add(&bar[XB_TOPGEN], 1u);
            else XB_SPIN(xb_ld(&bar[XB_TOPGEN]) == tg, bar);
            __builtin_amdgcn_fence(__ATOMIC_ACQUIRE, "agent");
            xb_add(&bar[XB_XGEN(b.x)], 1u);
            asm volatile("s_waitcnt vmcnt(0)" ::: "memory");
        } else {
            XB_SPIN(xb_ld(&bar[XB_XGEN(b.x)]) == gen, bar);
            __builtin_amdgcn_fence(__ATOMIC_ACQUIRE, "agent");
            asm volatile("s_waitcnt vmcnt(0)" ::: "memory");
        }
    }
    __syncthreads();
}

namespace pg8 {
constexpr int BM = 256, BK = 64, HALF = 128, HTB = HALF * BK * 2, STAGE_BYTES = 8 * HTB, NXCD = 8, WGM = 8;
DI int lds_byte(int r, int c) { const int st = (r >> 4) * 2 + (c >> 5), rr = r & 15, cc = c & 31, ob = rr * 64 + cc * 2; return st * 1024 + (ob ^ (((ob >> 9) & 1) << 5)); }
DI void stage_rc(int b, int& R, int& C) { const int st = b / 1024, sb = b % 1024, swz = sb ^ (((sb >> 9) & 1) << 5); R = (st >> 1) * 16 + swz / 64; C = (st & 1) * 32 + (swz % 64) / 2; }
struct Unit { int pm, pn; };
struct Gemm { const bf16_t* A; const bf16_t* Bt; int M, N, K; };
struct StaticOrder {
    int nM, nN, nwg, G, c;
    DI void init(int M, int N, int G_, int c_) { nM = M / BM; nN = N / BM; nwg = nM * nN; G = G_; c = c_; }
    DI bool next(int i, Unit& u) const {
        const long L = (long)i * G + c; if (L >= nwg) return false;
        int wgid = (int)L; { const int q = nwg / NXCD, r = nwg % NXCD, xcd = wgid % NXCD, off = wgid / NXCD; wgid = (xcd < r ? xcd * (q + 1) : r * (q + 1) + (xcd - r) * q) + off; }
        const int nig = WGM * nN, gid = wgid / nig, fm = gid * WGM, gsz = (nM - fm) < WGM ? (nM - fm) : WGM;
        u.pm = fm + ((wgid % nig) % gsz); u.pn = (wgid % nig) / gsz; return true;
    }
};

struct PairOrder {
    StaticOrder S; int dpm, dpn;
    DI bool next(int i, Unit& u) const { if (!S.next(i >> 1, u)) return false; if (i & 1) { u.pm += dpm; u.pn += dpn; } return true; }
};
template <class Epi, class Sched>
DI void gemm_phase(LAS unsigned char* lds, const Gemm g, const Sched& S, const Epi& E) {
    int tid_ = threadIdx.x; asm volatile("" : "+v"(tid_));
    const int tid = tid_, wid = __builtin_amdgcn_readfirstlane(tid >> 6), lane = tid & 63, wr = wid >> 2, wc = wid & 3, fr = lane & 15, fq = lane >> 4;
    const int K = g.K, nt = K / BK;
    unsigned voffA[2];
#pragma unroll
    for (int i = 0; i < 2; ++i) { int R, C; stage_rc(tid * 16 + i * 8192, R, C); voffA[i] = (unsigned)(R * K + C) * 2u; }
    const size_t kstep = (size_t)(BK * 2);
    const size_t hstep = (size_t)HALF * K * 2;
    const size_t tstep = 2 * hstep;
    const unsigned ldsw = (unsigned)wid * 1024u;
    const int aoff = lds_byte(wr * 64 + fr, fq * 8), boff = lds_byte(wc * 32 + fr, fq * 8);
#define PG8_SA(b, h) (((b) * 2 + (h)) * HTB)
#define PG8_SB(b, h) ((4 + (b) * 2 + (h)) * HTB)
#define PG8_STAGE(bufoff, gbase) do { _Pragma("unroll") for (int _i = 0; _i < 2; ++_i) \
        __builtin_amdgcn_global_load_lds((const unsigned*)((const char*)(gbase) + voffA[_i]), (LAS unsigned*)(lds + (bufoff) + ldsw + _i * 8192), 16, 0, 0); } while (0)
#define PG8_LDA(dst, b, h) do { _Pragma("unroll") for (int m = 0; m < 4; ++m) _Pragma("unroll") for (int k = 0; k < 2; ++k) dst[m][k] = *(const LAS bf16x8*)(lds + PG8_SA(b, h) + aoff + m * 2048 + k * 1024); } while (0)
#define PG8_LDB(dst, b, h) do { _Pragma("unroll") for (int n = 0; n < 2; ++n) _Pragma("unroll") for (int k = 0; k < 2; ++k) dst[n][k] = *(const LAS bf16x8*)(lds + PG8_SB(b, h) + boff + n * 2048 + k * 1024); } while (0)
#define PG8_MMA(ai, bj, At, Bt) do { __builtin_amdgcn_s_setprio(1); _Pragma("unroll") for (int m = 0; m < 4; ++m) _Pragma("unroll") for (int n = 0; n < 2; ++n) _Pragma("unroll") for (int k = 0; k < 2; ++k) \
        acc[ai][bj][m][n] = __builtin_amdgcn_mfma_f32_16x16x32_bf16(Bt[n][k], At[m][k], acc[ai][bj][m][n], 0, 0, 0); __builtin_amdgcn_s_setprio(0); } while (0)
#define PG8_WAIT_V(n) asm volatile("s_waitcnt vmcnt(" #n ")" ::: "memory")
#define PG8_WAIT_L(n) asm volatile("s_waitcnt lgkmcnt(" #n ")" ::: "memory")
#define PG8_BAR __builtin_amdgcn_s_barrier()
#define PG8_SCHED __builtin_amdgcn_sched_barrier(0)
    Unit cur, nxt; int ui = 0;
    if (!S.next(0, cur)) return;
    f32x4 acc[2][2][4][2];
#pragma unroll
    for (int a = 0; a < 2; ++a)
#pragma unroll
        for (int b = 0; b < 2; ++b)
#pragma unroll
            for (int m = 0; m < 4; ++m)
#pragma unroll
                for (int n = 0; n < 2; ++n) acc[a][b][m][n] = (f32x4){0.f, 0.f, 0.f, 0.f};
    bf16x8 At[4][2], B0[2][2], B1[2][2];
    const char* cA = (const char*)g.A + (size_t)cur.pm * tstep; const char* cB = (const char*)g.Bt + (size_t)cur.pn * tstep;
    PG8_STAGE(PG8_SB(0, 0), cB); PG8_STAGE(PG8_SB(0, 1), cB + hstep); PG8_STAGE(PG8_SA(0, 0), cA); PG8_STAGE(PG8_SA(0, 1), cA + hstep);
    if (wr == 1) PG8_BAR;
    PG8_WAIT_V(2); PG8_BAR;
    PG8_STAGE(PG8_SB(1, 0), cB + kstep); PG8_STAGE(PG8_SA(1, 0), cA + kstep); PG8_STAGE(PG8_SB(1, 1), cB + hstep + kstep);
    PG8_WAIT_V(6); PG8_BAR;
    for (;;) {
        const bool has_next = S.next(ui + 1, nxt);
        const char* nA = has_next ? (const char*)g.A + (size_t)nxt.pm * tstep : cA; const char* nB = has_next ? (const char*)g.Bt + (size_t)nxt.pn * tstep : cB;
        for (int t = 0; t < nt; t += 2) {
            const bool last = (t == nt - 2);
            const char* a1 = cA + (size_t)(t + 1) * kstep;
            const char* a2 = last ? nA : cA + (size_t)(t + 2) * kstep; const char* b2 = last ? nB : cB + (size_t)(t + 2) * kstep;
            const char* a3 = a2 + kstep; const char* b3 = b2 + kstep;
            PG8_LDB(B0, 0, 0); PG8_LDB(B1, 0, 1); PG8_SCHED; PG8_LDA(At, 0, 0); PG8_STAGE(PG8_SA(1, 1), a1 + hstep);
            PG8_WAIT_V(8); PG8_WAIT_L(0); PG8_BAR; PG8_MMA(0, 0, At, B0); PG8_MMA(0, 1, At, B1); PG8_BAR; PG8_SCHED;
            PG8_LDA(At, 0, 1); PG8_STAGE(PG8_SB(0, 0), b2); PG8_STAGE(PG8_SB(0, 1), b2 + hstep); PG8_STAGE(PG8_SA(0, 0), a2);
            PG8_WAIT_V(8); PG8_WAIT_L(0); PG8_BAR; PG8_MMA(1, 0, At, B0); PG8_MMA(1, 1, At, B1); PG8_BAR; PG8_SCHED;
            PG8_LDB(B0, 1, 0); PG8_LDB(B1, 1, 1); PG8_SCHED; PG8_LDA(At, 1, 0); PG8_STAGE(PG8_SA(0, 1), a2 + hstep);
            PG8_WAIT_V(8); PG8_WAIT_L(0); PG8_BAR; PG8_MMA(0, 0, At, B0); PG8_MMA(0, 1, At, B1); PG8_BAR; PG8_SCHED;
            PG8_LDA(At, 1, 1); PG8_STAGE(PG8_SB(1, 0), b3); PG8_STAGE(PG8_SB(1, 1), b3 + hstep); PG8_STAGE(PG8_SA(1, 0), a3);
            PG8_WAIT_V(8); PG8_WAIT_L(0); PG8_BAR; PG8_MMA(1, 0, At, B0); PG8_MMA(1, 1, At, B1); PG8_BAR; PG8_SCHED;
        }
        if (wr == 0) PG8_BAR;
        E(acc, cur, wr, wc, fr, fq);
        if (!has_next) break;
        if (!Epi::keep(cur))
#pragma unroll
        for (int a = 0; a < 2; ++a)
#pragma unroll
            for (int b = 0; b < 2; ++b)
#pragma unroll
                for (int m = 0; m < 4; ++m)
#pragma unroll
                    for (int n = 0; n < 2; ++n) acc[a][b][m][n] = (f32x4){0.f, 0.f, 0.f, 0.f};
        cur = nxt; cA = nA; cB = nB; ++ui;
        if (wr == 1) PG8_BAR;
    }
    PG8_WAIT_V(0);
    PG8_BAR;
#undef PG8_SA
#undef PG8_SB
#undef PG8_STAGE
#undef PG8_LDA
#undef PG8_LDB
#undef PG8_MMA
#undef PG8_WAIT_V
#undef PG8_WAIT_L
#undef PG8_BAR
#undef PG8_SCHED
}
}

typedef f32x4 AccT[2][2][4][2];

struct EpiQKV {
    static DI bool keep(const pg8::Unit&) { return false; }
    bf16_t* Q; float* AB; const float* biasp;
    DI void operator()(const AccT& acc, const pg8::Unit& u, int wr, int wc, int fr, int fq) const {
        const int row0 = u.pm * 256 + wr * 64 + fr;
        if (u.pn == 12) {
            if (wc == 0) {
                const f32x4 b0 = *(const f32x4*)(biasp + 12 * 256 + 4 * fq), b1 = *(const f32x4*)(biasp + 12 * 256 + 16 + 4 * fq);
#pragma unroll
                for (int ai = 0; ai < 2; ++ai)
#pragma unroll
                    for (int m = 0; m < 4; ++m) {
                        float* p = AB + (size_t)(row0 + ai * 128 + m * 16) * 32 + 8 * fq;
                        *(f32x4*)p = acc[ai][0][m][0] + b0; *(f32x4*)(p + 4) = acc[ai][0][m][1] + b1;
                    }
            }
        } else {
            bf16_t* base = Q + (size_t)(u.pn >> 2) * ((WS_K - WS_Q) / 2);
            const int colt = (u.pn & 3) * 256;
#pragma unroll
            for (int bj = 0; bj < 2; ++bj) {
                const int so = u.pn * 256 + bj * 128 + wc * 32 + 4 * fq;
                const f32x4 b0 = *(const f32x4*)(biasp + so), b1 = *(const f32x4*)(biasp + so + 16);
                const int col = colt + bj * 128 + wc * 32 + 8 * fq;
#pragma unroll
                for (int ai = 0; ai < 2; ++ai)
#pragma unroll
                    for (int m = 0; m < 4; ++m) {
                        const f32x4 v0 = acc[ai][bj][m][0] + b0, v1 = acc[ai][bj][m][1] + b1;
                        u32x4 w; w.x = pk2(v0[0], v0[1]); w.y = pk2(v0[2], v0[3]); w.z = pk2(v1[0], v1[1]); w.w = pk2(v1[2], v1[3]);
                        *(u32x4*)(base + (size_t)(row0 + ai * 128 + m * 16) * 1024 + col) = w;
                    }
            }
        }
    }
};

struct EpiRest {
    static DI bool keep(const pg8::Unit&) { return false; }
    bf16_t* ZA; bf16_t* YB; bf16_t* SA; bf16_t* SB; const float* biasp; const float* cw; const float* cb;
    DI void operator()(const AccT& acc, const pg8::Unit& u, int wr, int wc, int fr, int fq) const {
        const int row0 = u.pm * 256 + wr * 64 + fr;
        const int t = u.pn;
        if (t >= 4 && t < 20) {
            const int chl = 64 * (t - 4) + 16 * wc + 4 * fq;
            const int so = t * 256 + wc * 32 + 4 * fq;
            const f32x4 bxi = *(const f32x4*)(biasp + so), bcg = *(const f32x4*)(biasp + so + 16), bbg = *(const f32x4*)(biasp + so + 128), bzb = *(const f32x4*)(biasp + so + 144);
            const f32x4 w0 = *(const f32x4*)(cw + chl), w1 = *(const f32x4*)(cw + 1024 + chl), w2 = *(const f32x4*)(cw + 2048 + chl), cbv = *(const f32x4*)(cb + chl);
#pragma unroll
            for (int ai = 0; ai < 2; ++ai) {
                f32x4 xc[4], rp[4], rn[4];
#pragma unroll
                for (int m = 0; m < 4; ++m) {
                    xc[m] = (acc[ai][0][m][0] + bxi) * (acc[ai][0][m][1] + bcg);
#pragma unroll
                    for (int j = 0; j < 4; ++j) { rp[m][j] = dppf<0x121>(xc[m][j]); rn[m][j] = dppf<0x12F>(xc[m][j]); }
                }
#pragma unroll
                for (int m = 0; m < 4; ++m) {
                    f32x4 pv, nv;
#pragma unroll
                    for (int j = 0; j < 4; ++j) {
                        pv[j] = (fr == 0) ? (m > 0 ? rp[m > 0 ? m - 1 : 0][j] : 0.f) : rp[m][j];
                        nv[j] = (fr == 15) ? (m < 3 ? rn[m < 3 ? m + 1 : 3][j] : 0.f) : rn[m][j];
                    }
                    const f32x4 bg = acc[ai][1][m][0] + bbg, zb = acc[ai][1][m][1] + bzb;
                    float y[4];
#pragma unroll
                    for (int j = 0; j < 4; ++j) y[j] = bg[j] * siluf_(zb[j]) * (w0[j] * pv[j] + w1[j] * xc[m][j] + w2[j] * nv[j] + cbv[j]);
                    u32x2 w; w.x = pk2(y[0], y[1]); w.y = pk2(y[2], y[3]);
                    *(u32x2*)(YB + (size_t)(row0 + ai * 128 + m * 16) * 1024 + chl) = w;
                }
            }
            return;
        }
#pragma unroll
        for (int bj = 0; bj < 2; ++bj) {
            const int so = t * 256 + bj * 128 + wc * 32 + 4 * fq;
            const f32x4 b0 = *(const f32x4*)(biasp + so), b1 = *(const f32x4*)(biasp + so + 16);
            if (t < 4) {
                const int col = t * 256 + bj * 128 + wc * 32 + 8 * fq;
#pragma unroll
                for (int ai = 0; ai < 2; ++ai)
#pragma unroll
                    for (int m = 0; m < 4; ++m) {
                        f32x4 v0 = acc[ai][bj][m][0] + b0, v1 = acc[ai][bj][m][1] + b1;
#pragma unroll
                        for (int j = 0; j < 4; ++j) { v0[j] = siluf_(v0[j]); v1[j] = siluf_(v1[j]); }
                        u32x4 w; w.x = pk2(v0[0], v0[1]); w.y = pk2(v0[2], v0[3]); w.z = pk2(v1[0], v1[1]); w.w = pk2(v1[2], v1[3]);
                        *(u32x4*)(ZA + (size_t)(row0 + ai * 128 + m * 16) * 1024 + col) = w;
                    }
            } else if (bj == 0) {
                const int ch = (t - 20) * 128 + 32 * wc + 8 * fq;
                const int so1 = t * 256 + 128 + wc * 32 + 4 * fq;
                const f32x4 c0 = *(const f32x4*)(biasp + so1), c1 = *(const f32x4*)(biasp + so1 + 16);
#pragma unroll
                for (int ai = 0; ai < 2; ++ai)
#pragma unroll
                    for (int m = 0; m < 4; ++m) {
                        const f32x4 a0 = acc[ai][0][m][0] + b0, a1 = acc[ai][0][m][1] + b1, g0 = acc[ai][1][m][0] + c0, g1 = acc[ai][1][m][1] + c1;
                        const size_t o = (size_t)(row0 + ai * 128 + m * 16) * 1024 + ch;
                        float ea[8], ec[8];
#pragma unroll
                        for (int j = 0; j < 4; ++j) { ea[j] = 1.f + __expf(-a0[j]); ea[4 + j] = 1.f + __expf(-a1[j]); ec[j] = 1.f + __expf(-g0[j]); ec[4 + j] = 1.f + __expf(-g1[j]); }
                        u32x4 w, w2;
                        w.x = pk2(ec[0] * __builtin_amdgcn_rcpf(ea[0]), ec[1] * __builtin_amdgcn_rcpf(ea[1])); w.y = pk2(ec[2] * __builtin_amdgcn_rcpf(ea[2]), ec[3] * __builtin_amdgcn_rcpf(ea[3]));
                        w.z = pk2(ec[4] * __builtin_amdgcn_rcpf(ea[4]), ec[5] * __builtin_amdgcn_rcpf(ea[5])); w.w = pk2(ec[6] * __builtin_amdgcn_rcpf(ea[6]), ec[7] * __builtin_amdgcn_rcpf(ea[7]));
                        w2.x = pk2(__builtin_amdgcn_rcpf(ec[0]), __builtin_amdgcn_rcpf(ec[1])); w2.y = pk2(__builtin_amdgcn_rcpf(ec[2]), __builtin_amdgcn_rcpf(ec[3]));
                        w2.z = pk2(__builtin_amdgcn_rcpf(ec[4]), __builtin_amdgcn_rcpf(ec[5])); w2.w = pk2(__builtin_amdgcn_rcpf(ec[6]), __builtin_amdgcn_rcpf(ec[7]));
                        *(u32x4*)(SA + o) = w; *(u32x4*)(SB + o) = w2;
                    }
            }
        }
    }
};

struct EpiMergePair {
    static constexpr int DPM = 272, DPN = 4;
    bf16_t* MG; const bf16_t* SA; const bf16_t* SB;
    static DI bool keep(const pg8::Unit& u) { return u.pm < DPM; }
    DI void operator()(AccT& acc, const pg8::Unit& u, int wr, int wc, int fr, int fq) const {
        const bool first = u.pm < DPM;
        const int pm = first ? u.pm : u.pm - DPM, pn = first ? u.pn : u.pn - DPN;
        const int row0 = pm * 256 + wr * 64 + fr;
#pragma unroll
        for (int bj = 0; bj < 2; ++bj) {
            const int col = pn * 256 + bj * 128 + wc * 32 + 8 * fq;
#pragma unroll
            for (int ai = 0; ai < 2; ++ai)
#pragma unroll
                for (int m = 0; m < 4; ++m) {
                    const size_t o = (size_t)(row0 + ai * 128 + m * 16) * 1024 + col;
                    if (first) {
                        const u32x4 rv = *(const u32x4*)(SA + o);
                        const float rr[8] = {bflo(rv.x), bfhi(rv.x), bflo(rv.y), bfhi(rv.y), bflo(rv.z), bfhi(rv.z), bflo(rv.w), bfhi(rv.w)};
#pragma unroll
                        for (int j = 0; j < 4; ++j) { acc[ai][bj][m][0][j] *= rr[j]; acc[ai][bj][m][1][j] *= rr[4 + j]; }
                    } else {
                        const u32x4 bv = *(const u32x4*)(SB + o);
                        const float sb[8] = {bflo(bv.x), bfhi(bv.x), bflo(bv.y), bfhi(bv.y), bflo(bv.z), bfhi(bv.z), bflo(bv.w), bfhi(bv.w)};
                        const f32x4 v0 = acc[ai][bj][m][0], v1 = acc[ai][bj][m][1];
                        u32x4 w; w.x = pk2(v0[0] * sb[0], v0[1] * sb[1]); w.y = pk2(v0[2] * sb[2], v0[3] * sb[3]); w.z = pk2(v1[0] * sb[4], v1[1] * sb[5]); w.w = pk2(v1[2] * sb[6], v1[3] * sb[7]);
                        *(u32x4*)(MG + o) = w;
                    }
                }
        }
    }
};

struct EpiOut {
    static DI bool keep(const pg8::Unit&) { return false; }
    bf16_t* Y;
    DI void operator()(const AccT& acc, const pg8::Unit& u, int wr, int wc, int fr, int fq) const {
        const int row0 = u.pm * 256 + wr * 64 + fr;
#pragma unroll
        for (int bj = 0; bj < 2; ++bj) {
            const int col = u.pn * 256 + bj * 128 + wc * 32 + 8 * fq;
#pragma unroll
            for (int ai = 0; ai < 2; ++ai)
#pragma unroll
                for (int m = 0; m < 4; ++m) {
                    const f32x4 v0 = acc[ai][bj][m][0], v1 = acc[ai][bj][m][1];
                    u32x4 w; w.x = pk2(v0[0], v0[1]); w.y = pk2(v0[2], v0[3]); w.z = pk2(v1[0], v1[1]); w.w = pk2(v1[2], v1[3]);
                    *(u32x4*)(Y + (size_t)(row0 + ai * 128 + m * 16) * 1024 + col) = w;
                }
        }
    }
};

DI void prep_weight(LAS unsigned char* lds, const float* src, int ld, bf16_t* dst, int nslot, int mode, int& job, int G) {
    LAS float* tile = (LAS float*)lds;
    const int tid = threadIdx.x;
    const int ntile = (nslot / 64) * 16;
    const int sl_r = tid & 63, kl0 = tid >> 6;
    float v[8];
    auto ldtile = [&](int jb) {
        const int s0 = (jb >> 4) * 64, k0 = (jb & 15) * 64;
        const int sc = mode ? plaincol(s0 + sl_r) : srccol(s0 + sl_r);
#pragma unroll
        for (int e = 0; e < 8; ++e) v[e] = (sc >= 0) ? src[(size_t)(k0 + kl0 + 8 * e) * ld + sc] : 0.f;
    };
    if (job < ntile) ldtile(job);
    for (; job < ntile; job += G) {
        const int s0 = (job >> 4) * 64, k0 = (job & 15) * 64;
#pragma unroll
        for (int e = 0; e < 8; ++e) tile[(kl0 + 8 * e) * 65 + sl_r] = v[e];
        if (job + G < ntile) ldtile(job + G);
        lbar();
        {
            const int sl = tid >> 3, kq = tid & 7;
            float w8[8];
#pragma unroll
            for (int e = 0; e < 8; ++e) w8[e] = tile[(kq * 8 + e) * 65 + sl];
            u32x4 w; w.x = pk2(w8[0], w8[1]); w.y = pk2(w8[2], w8[3]); w.z = pk2(w8[4], w8[5]); w.w = pk2(w8[6], w8[7]);
            *(u32x4*)(dst + (size_t)(s0 + sl) * 1024 + k0 + kq * 8) = w;
        }
        lbar();
    }
    job -= ntile;
}

DI void phase0(const Params& p, LAS unsigned char* lds) {
    const int tid = threadIdx.x, G = gridDim.x;
    unsigned char* ws = p.ws;
    {
        LAS float* sc = (LAS float*)lds;
        LAS float* part = (LAS float*)(lds + 9 * 1024 * 4);
        const float* c = p.in[1]; const float* cctx = p.in[3]; const float* wmod = p.in[4]; const float* bmod = p.in[5];
        float* MOD = (float*)(ws + WS_MOD);
        for (int i = tid; i < 9 * 1024; i += NTHR) { const float v = (i < 8192) ? c[i] : cctx[i - 8192]; sc[i] = siluf_(v); }
        __syncthreads();
        for (int blk = blockIdx.x; blk < 256; blk += G) {
            if (tid < 504) {
                const int cl = tid % 12, kg = tid / 12;
                float a[9];
#pragma unroll
                for (int v = 0; v < 9; ++v) a[v] = 0.f;
#pragma unroll 5
                for (int k = kg; k < 1024; k += 42) {
                    const float w = wmod[(size_t)k * 3072 + blk * 12 + cl];
#pragma unroll
                    for (int v = 0; v < 9; ++v) a[v] += sc[v * 1024 + k] * w;
                }
#pragma unroll
                for (int v = 0; v < 9; ++v) part[(kg * 9 + v) * 12 + cl] = a[v];
            }
            __syncthreads();
            if (tid < 108) {
                const int v = tid / 12, cl = tid % 12;
                float s = 0.f;
                for (int kg = 0; kg < 42; ++kg) s += part[(kg * 9 + v) * 12 + cl];
                MOD[v * 3072 + blk * 12 + cl] = s + bmod[blk * 12 + cl];
            }
            __syncthreads();
        }
    }
    {
        float* BP = (float*)(ws + WS_BIASP); const float* bin = p.in[7];
        for (int s = blockIdx.x * NTHR + tid; s < NSLOT; s += G * NTHR) { const int sc = srccol(s); BP[s] = sc >= 0 ? bin[sc] : 0.f; }
    }
    int job = blockIdx.x;
    prep_weight(lds, p.in[6], INCOLS, (bf16_t*)(ws + WS_WINT), NSLOT, 0, job, G);
    prep_weight(lds, p.in[14], 1024, (bf16_t*)(ws + WS_WAT), 1024, 1, job, G);
    prep_weight(lds, p.in[15], 1024, (bf16_t*)(ws + WS_WBT), 1024, 1, job, G);
    prep_weight(lds, p.in[16], 1024, (bf16_t*)(ws + WS_WOT), 1024, 1, job, G);
}

DI void phase_ln_mod(const Params& p) {
    const int lane = threadIdx.x & 63, wid = threadIdx.x >> 6;
    const float* MOD = (const float*)(p.ws + WS_MOD);
    bf16_t* HX = (bf16_t*)(p.ws + WS_QKHX);
    const int stride = gridDim.x * 8;
    int row = blockIdx.x * 8 + wid;
    f32x4 xv[4], nx[4];
    auto rowsrc = [&](int r) { return (r < XR) ? p.in[0] + (size_t)r * 1024 : p.in[2] + (size_t)(r - XR) * 1024; };
    if (row < ROWS) {
        const float* src = rowsrc(row);
#pragma unroll
        for (int i = 0; i < 4; ++i) xv[i] = ld_nt((const f32x4*)(src + i * 256 + lane * 4));
    }
    for (; row < ROWS; row += stride) {
        const int v = (row < XR) ? (row >> 12) : 8;
        if (row + stride < ROWS) {
            const float* src = rowsrc(row + stride);
#pragma unroll
            for (int i = 0; i < 4; ++i) nx[i] = ld_nt((const f32x4*)(src + i * 256 + lane * 4));
        }
        float s = 0.f;
#pragma unroll
        for (int i = 0; i < 4; ++i) s += xv[i][0] + xv[i][1] + xv[i][2] + xv[i][3];
#pragma unroll
        for (int o = 1; o < 64; o <<= 1) s += __shfl_xor(s, o);
        const float mu = s * (1.f / 1024.f);
        float q = 0.f;
#pragma unroll
        for (int i = 0; i < 4; ++i)
#pragma unroll
            for (int j = 0; j < 4; ++j) { const float d = xv[i][j] - mu; q += d * d; }
#pragma unroll
        for (int o = 1; o < 64; o <<= 1) q += __shfl_xor(q, o);
        const float rstd = rsqrtf(q * (1.f / 1024.f) + 1e-5f);
#pragma unroll
        for (int i = 0; i < 4; ++i) {
            const int col = i * 256 + lane * 4;
            const f32x4 sh = *(const f32x4*)(MOD + v * 3072 + col), scl = *(const f32x4*)(MOD + v * 3072 + 1024 + col);
            float y[4];
#pragma unroll
            for (int j = 0; j < 4; ++j) y[j] = (xv[i][j] - mu) * rstd * (1.f + scl[j]) + sh[j];
            u32x2 w; w.x = pk2(y[0], y[1]); w.y = pk2(y[2], y[3]);
            *(u32x2*)(HX + (size_t)row * 1024 + col) = w;
        }
#pragma unroll
        for (int i = 0; i < 4; ++i) xv[i] = nx[i];
    }
}

constexpr int P3_QS = 0, P3_KS = 17408, P3_VT = 34816, P3_KT = 53248, P3_M = 71680, P3_TB = 104448, P3_GC = 141312, P3_BETA = 141824;
#define MFMA32(a, b, c) __builtin_amdgcn_mfma_f32_32x32x16_bf16((a), (b), (c), 0, 0, 0)

DI void phase_gdn_pre(const Params& p, LAS unsigned char* lds, const bool dry) {
    const int tid = threadIdx.x, lane = tid & 63, wid = __builtin_amdgcn_readfirstlane(tid >> 6), r = lane & 31, hh = lane >> 5;
    unsigned char* ws = p.ws;
    bf16_t* Qb = (bf16_t*)(ws + WS_Q); bf16_t* Kb = (bf16_t*)(ws + WS_K); bf16_t* Vb = (bf16_t*)(ws + WS_V);
    bf16_t* QC = (bf16_t*)(ws + WS_QC); bf16_t* KC = (bf16_t*)(ws + WS_KC);
    const float* AB = (const float*)(ws + WS_AB); float* GCg = (float*)(ws + WS_GC);
    bf16_t* Ug = (bf16_t*)(ws + WS_U);
    bf16_t* WX = (bf16_t*)p.out; bf16_t* WCTX = (bf16_t*)(ws + WS_WCTX);
    const float* convw = p.in[8]; const float* alog = p.in[9]; const float* dtbias = p.in[10];
    LAS float* const gcs_all = (LAS float*)(lds + P3_GC2); LAS float* const betas_all = (LAS float*)(lds + P3_BETA2);
    LAS float* Ms = (LAS float*)(lds + P3_M);

    unsigned raw[3][6][2]; float abv[2] = {0.f, 0.f};
    auto load_raw = [&](int it) {
        const bool isx = it < 4096;
        int b, h, n;
        if (isx) { b = it >> 9; h = (it >> 6) & 7; n = it & 63; } else { const int ci = it - 4096; b = ci >> 5; h = (ci >> 2) & 7; n = ci & 3; }
        const size_t rowbase = isx ? (size_t)b * 4096 + n * 64 : (size_t)XR + b * 256 + n * 64;
        const int seqpos0 = isx ? 0 : n * 64, seqlen = isx ? 64 : 256;
        const int tg = tid >> 5, cq = tid & 31;
#pragma unroll
        for (int sec = 0; sec < 3; ++sec) {
            const bf16_t* src = (sec == 0 ? Qb : (sec == 1 ? Kb : Vb)) + rowbase * 1024 + h * 128 + 4 * cq;
#pragma unroll
            for (int rr = 0; rr < 6; ++rr) {
                const int lt = 4 * tg - 1 + rr, pos = seqpos0 + lt;
                u32x2 v = {0u, 0u};
                if (pos >= 0 && pos < seqlen) v = *(const u32x2*)(src + (long)lt * 1024);
                raw[sec][rr][0] = v.x; raw[sec][rr][1] = v.y;
            }
        }
        if (wid == 4 || wid == 5) {
            const int d = wid - 4, lt = d ? 63 - lane : lane;
            abv[0] = AB[(rowbase + lt) * 32 + d * 8 + h]; abv[1] = AB[(rowbase + lt) * 32 + 16 + d * 8 + h];
        }
    };
    auto bstage = [&](int it2, int buf) {
        const bool isx2 = it2 < 4096;
        int b2, h2, n2;
        if (isx2) { b2 = it2 >> 9; h2 = (it2 >> 6) & 7; n2 = it2 & 63; } else { const int ci = it2 - 4096; b2 = ci >> 5; h2 = (ci >> 2) & 7; n2 = ci & 3; }
        const int gchunk2 = isx2 ? 4 + n2 : n2;
        const int d = wid - 4, cp = lane;
        const float a = abv[0], bl = abv[1];
        const float arate = __expf(alog[d * 8 + h2]), dtb = dtbias[d * 8 + h2];
        const float xx = a + dtb;
        const float ee = __expf(-fabsf(xx));
        const float l1p = (ee < 0.03125f) ? ee * (1.f + ee * (-0.5f + ee * (0.33333333f - 0.25f * ee))) : __logf(1.f + ee);
        const float sp = fmaxf(xx, 0.f) + l1p;
        float g = -arate * sp;
#pragma unroll
        for (int o = 1; o < 64; o <<= 1) { const float t = __shfl_up(g, o); if (lane >= o) g += t; }
        gcs_all[buf * 128 + d * 64 + cp] = g; betas_all[buf * 128 + d * 64 + cp] = sigmoidf_(bl);
        GCg[((size_t)((b2 * 8 + h2) * 2 + d) * NCHUNK + gchunk2) * 64 + cp] = g;
    };
    const int hA = (blockIdx.x >> 6) & 7, hB = (hA + 4) & 7;
    LAS float* CW = (LAS float*)(lds + P3_CW);
    for (int i = tid; i < 2304; i += NTHR) {
        const int hs = i / 1152, rem = i % 1152, tap = rem / 384, c = rem % 384;
        CW[i] = convw[tap * 3072 + (c >> 7) * 1024 + (hs ? hB : hA) * 128 + (c & 127)];
    }
    if (blockIdx.x < 4352) { load_raw(blockIdx.x); if (wid == 4 || wid == 5) bstage(blockIdx.x, 0); }
    lbar();
    int kit = 0;
    for (int it = blockIdx.x; it < 4352; it += gridDim.x, ++kit) {
        LAS float* gcs = gcs_all + (kit & 1) * 128; LAS float* betas = betas_all + (kit & 1) * 128;
        const bool isx = it < 4096;
        int b, h, n;
        if (isx) { b = it >> 9; h = (it >> 6) & 7; n = it & 63; } else { const int ci = it - 4096; b = ci >> 5; h = (ci >> 2) & 7; n = ci & 3; }
        const int gchunk = isx ? 4 + n : n;
        const size_t rowbase = isx ? (size_t)b * 4096 + n * 64 : (size_t)XR + b * 256 + n * 64;
        const int tg = tid >> 5, cq = tid & 31;
        unsigned pk[3][4][2];
#pragma unroll
        for (int sec = 0; sec < 3; ++sec) {
            float in[6][4];
#pragma unroll
            for (int rr = 0; rr < 6; ++rr) { in[rr][0] = bflo(raw[sec][rr][0]); in[rr][1] = bfhi(raw[sec][rr][0]); in[rr][2] = bflo(raw[sec][rr][1]); in[rr][3] = bfhi(raw[sec][rr][1]); }
            f32x4 w0, w1, w2;
            if (h == hA || h == hB) {
                const LAS float* cwp = CW + (h == hA ? 0 : 1152) + sec * 128 + 4 * cq;
                w0 = *(const LAS f32x4*)cwp; w1 = *(const LAS f32x4*)(cwp + 384); w2 = *(const LAS f32x4*)(cwp + 768);
            } else {
                w0 = *(const f32x4*)(convw + 0 * 3072 + sec * 1024 + h * 128 + 4 * cq);
                w1 = *(const f32x4*)(convw + 1 * 3072 + sec * 1024 + h * 128 + 4 * cq);
                w2 = *(const f32x4*)(convw + 2 * 3072 + sec * 1024 + h * 128 + 4 * cq);
            }
#pragma unroll
            for (int t = 0; t < 4; ++t) {
                float o4[4];
#pragma unroll
                for (int j = 0; j < 4; ++j) o4[j] = siluf_(w0[j] * in[t][j] + w1[j] * in[t + 1][j] + w2[j] * in[t + 2][j]);
                if (sec < 2) {
                    const float ss = sum32(o4[0] * o4[0] + o4[1] * o4[1] + o4[2] * o4[2] + o4[3] * o4[3]);
                    const float rs = rsqrtf(ss + 1e-6f) * (sec == 0 ? 0.08838834764831845f : 1.f);
#pragma unroll
                    for (int j = 0; j < 4; ++j) o4[j] *= rs;
                }
                pk[sec][t][0] = pk2(o4[0], o4[1]); pk[sec][t][1] = pk2(o4[2], o4[3]);
            }
        }
        lbar();
        {
            bf16_t* qd = isx ? Qb + rowbase * 1024 : QC + ((size_t)b * 256 + n * 64) * 1024;
            bf16_t* kd = isx ? Kb + rowbase * 1024 : KC + ((size_t)b * 256 + n * 64) * 1024;
#pragma unroll
            for (int t = 0; t < 4; ++t) {
                const int lt = 4 * tg + t;
                u32x2 wq = {pk[0][t][0], pk[0][t][1]}, wk = {pk[1][t][0], pk[1][t][1]};
                if (!dry) {
                    *(u32x2*)(qd + (size_t)lt * 1024 + h * 128 + 4 * cq) = wq;
                    *(u32x2*)(kd + (size_t)lt * 1024 + h * 128 + 4 * cq) = wk;
                }
                *(LAS u32x2*)(lds + P3_QS + lt * 272 + 8 * cq) = wq;
                *(LAS u32x2*)(lds + P3_KS + lt * 272 + 8 * cq) = wk;
            }
#pragma unroll
            for (int j = 0; j < 4; ++j) {
                const int sh = (j & 1) * 16, wi = j >> 1;
                u32x2 tk, tv;
                tk.x = ((pk[1][0][wi] >> sh) & 0xffffu) | (((pk[1][1][wi] >> sh) & 0xffffu) << 16);
                tk.y = ((pk[1][2][wi] >> sh) & 0xffffu) | (((pk[1][3][wi] >> sh) & 0xffffu) << 16);
                tv.x = ((pk[2][0][wi] >> sh) & 0xffffu) | (((pk[2][1][wi] >> sh) & 0xffffu) << 16);
                tv.y = ((pk[2][2][wi] >> sh) & 0xffffu) | (((pk[2][3][wi] >> sh) & 0xffffu) << 16);
                *(LAS u32x2*)(lds + P3_KT + (4 * cq + j) * 144 + 8 * tg) = tk;
                *(LAS u32x2*)(lds + P3_VT + (4 * cq + j) * 144 + 8 * tg) = tv;
            }
        }
        lbar();
        if (it + (int)gridDim.x < 4352) load_raw(it + gridDim.x);
        {
            const int sel = wid >> 2, mt = (wid >> 1) & 1, nt = wid & 1;
            const LAS unsigned char* Ab = lds + (sel ? P3_QS : P3_KS) + (32 * mt + r) * 272 + 16 * hh;
            const LAS unsigned char* Bb = lds + P3_KS + (32 * nt + r) * 272 + 16 * hh;
            f32x16 acc;
#pragma unroll
            for (int i = 0; i < 16; ++i) acc[i] = 0.f;
#pragma unroll
            for (int ks = 0; ks < 8; ++ks) acc = MFMA32(*(const LAS bf16x8*)(Ab + 32 * ks), *(const LAS bf16x8*)(Bb + 32 * ks), acc);
            const int s = 32 * nt + r, cb = 32 * mt + 4 * hh;
#pragma unroll
            for (int d = 0; d < 2; ++d) {
                const int sp = d ? 63 - s : s, cpb = d ? 63 - cb : cb;
                const float gs = gcs[d * 64 + sp];
                const LAS float* gb = gcs + d * 64 + cpb; const LAS float* bb = betas + d * 64 + cpb;
                LAS float* mb = Ms + d * 4096 + cpb * 64 + sp;
                bf16_t* qb = Vb + (rowbase + cpb) * 1024 + h * 128 + d * 64 + sp;
                float vq[16];
#pragma unroll
                for (int i = 0; i < 16; ++i) {
                    const int dc = d ? -((i & 3) + 8 * (i >> 2)) : ((i & 3) + 8 * (i >> 2));
                    const int cp = cpb + dc;
                    const float e = __expf(gb[dc] - gs);
                    if (sel == 0) mb[dc * 64] = (sp < cp) ? bb[dc] * acc[i] * e : 0.f;
                    else vq[i] = (sp <= cp) ? acc[i] * e : 0.f;
                }
                if (sel == 1 && isx && !dry) {
                    const bool lowlane = (sp & 1) == 0;
                    bf16_t* qb2 = Vb + (rowbase + cpb) * 1024 + h * 128 + d * 64 + (sp & ~1);
#pragma unroll
                    for (int i = 0; i < 16; i += 2) {
                        const int dc0 = d ? -((i & 3) + 8 * (i >> 2)) : ((i & 3) + 8 * (i >> 2));
                        const int dc1 = d ? -(((i + 1) & 3) + 8 * ((i + 1) >> 2)) : (((i + 1) & 3) + 8 * ((i + 1) >> 2));
                        const float recv = dppf<0xB1>(lowlane ? vq[i + 1] : vq[i]);
                        const unsigned w = lowlane ? pk2(vq[i], recv) : pk2(recv, vq[i + 1]);
                        *(unsigned*)(qb2 + (lowlane ? dc0 : dc1) * 1024) = w;
                    }
                }
            }
        }
        lbar();
        if (wid < 2) {
            const int d = wid; int ln = lane; asm volatile("" : "+v"(ln));
            const int half = ln >> 5, jj = ln & 31;
            LAS float* Mr = Ms + d * 4096;
            const LAS float* Mb = Mr + (32 * half) * 64 + 32 * half;
            float t[32];
            t[0] = (jj == 0) ? 1.f : 0.f;
#pragma unroll
            for (int i = 1; i < 32; ++i) {
                f32x4 cur[8];
#pragma unroll
                for (int l4 = 0; l4 < (i + 3) / 4; ++l4) cur[l4] = *(const LAS f32x4*)(Mb + i * 64 + 4 * l4);
                __builtin_amdgcn_sched_barrier(0);
                float a0 = (i == jj) ? 1.f : 0.f, a1 = 0.f, a2 = 0.f, a3 = 0.f;
#pragma unroll
                for (int l4 = 0; l4 < (i + 3) / 4; ++l4) {
                    if (4 * l4 + 0 < i) a0 -= cur[l4][0] * t[4 * l4 + 0];
                    if (4 * l4 + 1 < i) a1 -= cur[l4][1] * t[4 * l4 + 1];
                    if (4 * l4 + 2 < i) a2 -= cur[l4][2] * t[4 * l4 + 2];
                    if (4 * l4 + 3 < i) a3 -= cur[l4][3] * t[4 * l4 + 3];
                }
                t[i] = (a0 + a1) + (a2 + a3);
                __builtin_amdgcn_sched_barrier(0);
            }
            if (half == 0) {
#pragma unroll
                for (int q = 0; q < 8; ++q) *(LAS f32x4*)(Mr + jj * 64 + 32 + 4 * q) = (f32x4){t[4 * q], t[4 * q + 1], t[4 * q + 2], t[4 * q + 3]};
            } else {
#pragma unroll
                for (int i = 0; i < 32; ++i) Mr[i * 64 + jj] = t[i];
            }
            f32x4 av[4], bv[4];
#pragma unroll
            for (int q = 0; q < 4; ++q) { av[q] = *(const LAS f32x4*)(Mr + (32 + jj) * 64 + 16 * half + 4 * q); bv[q] = *(const LAS f32x4*)(Mr + jj * 64 + 32 + 16 * half + 4 * q); }
            f32x16 P, R;
#pragma unroll
            for (int i = 0; i < 16; ++i) { P[i] = 0.f; R[i] = 0.f; }
#pragma unroll
            for (int ks = 0; ks < 16; ++ks) P = __builtin_amdgcn_mfma_f32_32x32x2f32(av[ks >> 2][ks & 3], bv[ks >> 2][ks & 3], P, 0, 0, 0);
            f32x4 a2v[4];
#pragma unroll
            for (int q = 0; q < 4; ++q) a2v[q] = *(const LAS f32x4*)(Mr + jj * 64 + 8 * q + 4 * half);
#pragma unroll
            for (int ks = 0; ks < 16; ++ks) R = __builtin_amdgcn_mfma_f32_32x32x2f32(a2v[ks >> 2][ks & 3], P[ks], R, 0, 0, 0);
            {
                const int spA = 32 * half + jj, spB = jj;
                const float bA = betas[d * 64 + spA], eA = bA * __expf(gcs[d * 64 + spA]);
                const float bB = betas[d * 64 + spB], eB = bB * __expf(gcs[d * 64 + spB]);
                const int colA = d ? 63 - spA : spA, colB = d ? 63 - spB : spB;
                LAS bf16_t* tb = (LAS bf16_t*)(lds + P3_TB + (d * 2 + 0) * 9216);
                LAS bf16_t* tg2 = (LAS bf16_t*)(lds + P3_TB + (d * 2 + 1) * 9216);
#pragma unroll
                for (int i = 0; i < 32; ++i) {
                    tb[(32 * half + i) * 72 + colA] = f2bf(t[i] * bA); tg2[(32 * half + i) * 72 + colA] = f2bf(-t[i] * eA);
                }
                if (half == 1) {
#pragma unroll
                    for (int i = 0; i < 32; ++i) { tb[i * 72 + colA] = 0; tg2[i * 72 + colA] = 0; }
                }
#pragma unroll
                for (int i = 0; i < 16; ++i) {
                    const int rr = 32 + crow(i, half);
                    tb[rr * 72 + colB] = f2bf(-R[i] * bB); tg2[rr * 72 + colB] = f2bf(R[i] * eB);
                }
            }
        }
        if ((wid == 4 || wid == 5) && it + (int)gridDim.x < 4352) bstage(it + gridDim.x, (kit + 1) & 1);
        lbar();
        {
            const int d = wid & 1, kind = (wid >> 1) & 1, tq = wid >> 2;
            const size_t idx = (size_t)((b * 8 + h) * 2 + d) * NCHUNK + gchunk;
            const LAS unsigned char* T = lds + P3_TB + (d * 2 + kind) * 9216;
#pragma unroll
            for (int q = 0; q < 4; ++q) {
                const int tl = tq * 4 + q;
                f32x16 acc;
#pragma unroll
                for (int i = 0; i < 16; ++i) acc[i] = 0.f;
                if (kind == 0) {
                    const int mt = tl & 1, nt = tl >> 1;
                    const LAS unsigned char* Ab = T + (32 * mt + r) * 144 + 16 * hh;
                    const LAS unsigned char* Bb = lds + P3_VT + (32 * nt + r) * 144 + 16 * hh;
#pragma unroll
                    for (int ks = 0; ks < 4; ++ks) acc = MFMA32(*(const LAS bf16x8*)(Ab + 32 * ks), *(const LAS bf16x8*)(Bb + 32 * ks), acc);
                    u32x4 w0, w1;
                    w0.x = pk2(acc[0], acc[1]); w0.y = pk2(acc[2], acc[3]); w0.z = pk2(acc[4], acc[5]); w0.w = pk2(acc[6], acc[7]);
                    w1.x = pk2(acc[8], acc[9]); w1.y = pk2(acc[10], acc[11]); w1.z = pk2(acc[12], acc[13]); w1.w = pk2(acc[14], acc[15]);
                    bf16_t* dst = Ug + idx * 8192 + ((nt * 2 + mt) * 64 + lane) * 16;
                    *(u32x4*)dst = w0; *(u32x4*)(dst + 8) = w1;
                } else {
                    const int mt = tl & 3, nt = tl >> 2;
                    const LAS unsigned char* Ab = lds + P3_KT + (32 * mt + r) * 144 + 16 * hh;
                    const LAS unsigned char* Bb = T + (32 * nt + r) * 144 + 16 * hh;
#pragma unroll
                    for (int ks = 0; ks < 4; ++ks) acc = MFMA32(*(const LAS bf16x8*)(Ab + 32 * ks), *(const LAS bf16x8*)(Bb + 32 * ks), acc);
                    bf16_t* wblk = isx ? WX + ((size_t)((b * 8 + h) * 2 + d) * 64 + n) * 8192 : WCTX + ((size_t)((b * 8 + h) * 2 + d) * 4 + n) * 8192;
                    bf16_t* dst = wblk + (32 * nt + r) * 128 + 32 * mt + 4 * hh;
#pragma unroll
                    for (int g4 = 0; g4 < 4; ++g4) {
                        u32x2 w; w.x = pk2(acc[4 * g4], acc[4 * g4 + 1]); w.y = pk2(acc[4 * g4 + 2], acc[4 * g4 + 3]);
                        *(u32x2*)(dst + 8 * g4) = w;
                    }
                }
            }
        }
        lbar();
    }
}

constexpr int P4_QD = 0, P4_W = 16896, P4_KDT = 33792, P4_QK = 51200, P4_DEC = 59904, P4_BUF = 59920;

DI bf16x8 ldsA(const LAS unsigned char* p) {
    const s16x4 lo = *(const LAS s16x4*)p, hi = *(const LAS s16x4*)(p + 16);
    return __builtin_shufflevector(lo, hi, 0, 1, 2, 3, 4, 5, 6, 7);
}
DI bf16x8 packf(const f32x16& x, int s) {
    u32x4 w; w.x = pk2(x[8 * s], x[8 * s + 1]); w.y = pk2(x[8 * s + 2], x[8 * s + 3]); w.z = pk2(x[8 * s + 4], x[8 * s + 5]); w.w = pk2(x[8 * s + 6], x[8 * s + 7]);
    return __builtin_bit_cast(bf16x8, w);
}

DI void phase_gdn_scan(const Params& p, LAS unsigned char* lds, const bool dry) {
    if (blockIdx.x >= 256) return;
    const int tid = threadIdx.x, lane = tid & 63, wid = __builtin_amdgcn_readfirstlane(tid >> 6), r = lane & 31, hh = lane >> 5;
    unsigned char* ws = p.ws;
    const int chain = blockIdx.x & 127, dvh = blockIdx.x >> 7, b = chain >> 4, h = (chain >> 1) & 7, d = chain & 1;
    const bf16_t* Qb = (const bf16_t*)(ws + WS_Q); const bf16_t* Kb = (const bf16_t*)(ws + WS_K);
    const bf16_t* QC = (const bf16_t*)(ws + WS_QC); const bf16_t* KC = (const bf16_t*)(ws + WS_KC);
    const float* GCg = (const float*)(ws + WS_GC);
    bf16_t* Ug = (bf16_t*)(ws + WS_U); const bf16_t* Vb = (const bf16_t*)(ws + WS_V);
    const bf16_t* WX = (const bf16_t*)p.out; const bf16_t* WCTX = (const bf16_t*)(ws + WS_WCTX);
    const size_t cbase = (size_t)((b * 8 + h) * 2 + d);
    auto gchunk_of = [&](int j) { return d ? (j < 4 ? 3 - j : 71 - j) : j; };

    u32x4 qv[4], kv[4], wv[4], qkv[2]; float gcv = 0.f, gl = 0.f;
    const int ptid = tid - 256, pcp = ptid >> 2, part = ptid & 3, plt = d ? 63 - pcp : pcp;
    auto issue = [&](int j) {
        const int g = gchunk_of(j);
        const size_t idx = cbase * NCHUNK + g;
        const size_t rowoff = (g < 4) ? ((size_t)b * 256 + g * 64 + plt) * 1024 : ((size_t)b * 4096 + (g - 4) * 64 + plt) * 1024;
        const bf16_t* qs = ((g < 4) ? QC : Qb) + rowoff + h * 128 + part * 32;
        const bf16_t* ks = ((g < 4) ? KC : Kb) + rowoff + h * 128 + part * 32;
        const bf16_t* wsrc = ((g < 4) ? WCTX + (cbase * 4 + g) * 8192 : WX + (cbase * 64 + (g - 4)) * 8192) + pcp * 128 + part * 32;
        const bf16_t* qks = Vb + ((g < 4) ? ((size_t)XR + b * 256 + g * 64 + pcp) : ((size_t)b * 4096 + (g - 4) * 64 + pcp)) * 1024 + h * 128 + d * 64 + part * 16;
#pragma unroll
        for (int i = 0; i < 4; ++i) { qv[i] = *(const u32x4*)(qs + 8 * i); kv[i] = *(const u32x4*)(ks + 8 * i); wv[i] = *(const u32x4*)(wsrc + 8 * i); }
        qkv[0] = *(const u32x4*)qks; qkv[1] = *(const u32x4*)(qks + 8);
        gcv = GCg[idx * 64 + pcp]; gl = GCg[idx * 64 + 63];
    };
    auto commit = [&](int j) {
        const float eq = __expf(gcv), ek = __expf(gl - gcv);
        LAS unsigned char* buf = lds + (j & 1) * P4_BUF;
        if (ptid == 0) *(LAS float*)(buf + P4_DEC) = __expf(gl);
        LAS unsigned char* qd = buf + P4_QD + pcp * 264 + part * 64;
        LAS unsigned char* wd = buf + P4_W + pcp * 264 + part * 64;
#pragma unroll
        for (int i = 0; i < 4; ++i) {
            u32x2 a, c2;
            a.x = pk2(bflo(qv[i].x) * eq, bfhi(qv[i].x) * eq); a.y = pk2(bflo(qv[i].y) * eq, bfhi(qv[i].y) * eq);
            c2.x = pk2(bflo(qv[i].z) * eq, bfhi(qv[i].z) * eq); c2.y = pk2(bflo(qv[i].w) * eq, bfhi(qv[i].w) * eq);
            *(LAS u32x2*)(qd + 16 * i) = a; *(LAS u32x2*)(qd + 16 * i + 8) = c2;
            u32x2 w0 = {wv[i].x, wv[i].y}, w1 = {wv[i].z, wv[i].w};
            *(LAS u32x2*)(wd + 16 * i) = w0; *(LAS u32x2*)(wd + 16 * i + 8) = w1;
        }
        LAS unsigned char* qkd = buf + P4_QK + pcp * 136 + part * 32;
#pragma unroll
        for (int i = 0; i < 2; ++i) {
            u32x2 w0 = {qkv[i].x, qkv[i].y}, w1 = {qkv[i].z, qkv[i].w};
            *(LAS u32x2*)(qkd + 16 * i) = w0; *(LAS u32x2*)(qkd + 16 * i + 8) = w1;
        }
        LAS bf16_t* kdt = (LAS bf16_t*)(buf + P4_KDT) + (part * 32) * 68 + pcp;
#pragma unroll
        for (int i = 0; i < 4; ++i) {
            const unsigned uu[4] = {kv[i].x, kv[i].y, kv[i].z, kv[i].w};
#pragma unroll
            for (int e = 0; e < 4; ++e) {
                const unsigned pk = pk2(bflo(uu[e]) * ek, bfhi(uu[e]) * ek);
                kdt[(8 * i + 2 * e) * 68] = (bf16_t)(pk & 0xffffu);
                kdt[(8 * i + 2 * e + 1) * 68] = (bf16_t)(pk >> 16);
            }
        }
    };

    f32x16 S[4];
#pragma unroll
    for (int m = 0; m < 4; ++m)
#pragma unroll
        for (int i = 0; i < 16; ++i) S[m][i] = 0.f;
    u32x4 un[4];
    auto loadu = [&](int j, u32x4 (&dst)[4]) {
        const bf16_t* up = Ug + (cbase * NCHUNK + gchunk_of(j)) * 8192 + (size_t)(((2 * dvh + wid) * 2) * 64 + lane) * 16;
        dst[0] = *(const u32x4*)up; dst[1] = *(const u32x4*)(up + 8); dst[2] = *(const u32x4*)(up + 1024); dst[3] = *(const u32x4*)(up + 1024 + 8);
    };
    if (wid >= 4) {
        issue(0); commit(0); issue(1);
        lbar();
        for (int j = 0; j < NCHUNK; ++j) {
            if (j + 1 < NCHUNK) commit(j + 1);
            if (j + 2 < NCHUNK) issue(j + 2);
            lbar();
        }
        return;
    }
    if (wid >= 2) { lbar(); for (int j = 0; j < NCHUNK; ++j) lbar(); return; }
    loadu(0, un);
    lbar();
    for (int j = 0; j < NCHUNK; ++j) {
        {
            const int g = gchunk_of(j);
            const size_t idx = cbase * NCHUNK + g;
            const LAS unsigned char* buf = lds + (j & 1) * P4_BUF;
            const float dec = *(const LAS float*)(buf + P4_DEC);
            f32x16 vn[2];
#pragma unroll
            for (int mt = 0; mt < 2; ++mt) {
                const u32x4 a = un[2 * mt], c2 = un[2 * mt + 1];
                vn[mt][0] = bflo(a.x); vn[mt][1] = bfhi(a.x); vn[mt][2] = bflo(a.y); vn[mt][3] = bfhi(a.y);
                vn[mt][4] = bflo(a.z); vn[mt][5] = bfhi(a.z); vn[mt][6] = bflo(a.w); vn[mt][7] = bfhi(a.w);
                vn[mt][8] = bflo(c2.x); vn[mt][9] = bfhi(c2.x); vn[mt][10] = bflo(c2.y); vn[mt][11] = bfhi(c2.y);
                vn[mt][12] = bflo(c2.z); vn[mt][13] = bfhi(c2.z); vn[mt][14] = bflo(c2.w); vn[mt][15] = bfhi(c2.w);
            }
            if (j + 1 < NCHUNK) loadu(j + 1, un);
            bf16x8 Sb[8];
#pragma unroll
            for (int kk = 0; kk < 8; ++kk) Sb[kk] = packf(S[kk >> 1], kk & 1);
            f32x16 o[2];
#pragma unroll
            for (int i = 0; i < 16; ++i) { o[0][i] = 0.f; o[1][i] = 0.f; }
            bf16x8 vb[4];
            bf16x8 fa[8], fb[8];
            fa[0] = ldsA(buf + P4_W + (32 * 0 + r) * 264 + 8 * hh + 32 * 0);
            fa[1] = ldsA(buf + P4_W + (32 * 1 + r) * 264 + 8 * hh + 32 * 0);
            fa[2] = ldsA(buf + P4_W + (32 * 0 + r) * 264 + 8 * hh + 32 * 1);
            fa[3] = ldsA(buf + P4_W + (32 * 1 + r) * 264 + 8 * hh + 32 * 1);
            fa[4] = ldsA(buf + P4_W + (32 * 0 + r) * 264 + 8 * hh + 32 * 2);
            fa[5] = ldsA(buf + P4_W + (32 * 1 + r) * 264 + 8 * hh + 32 * 2);
            fa[6] = ldsA(buf + P4_W + (32 * 0 + r) * 264 + 8 * hh + 32 * 3);
            fa[7] = ldsA(buf + P4_W + (32 * 1 + r) * 264 + 8 * hh + 32 * 3);
            fb[0] = ldsA(buf + P4_W + (32 * 0 + r) * 264 + 8 * hh + 32 * 4);
            fb[1] = ldsA(buf + P4_W + (32 * 1 + r) * 264 + 8 * hh + 32 * 4);
            fb[2] = ldsA(buf + P4_W + (32 * 0 + r) * 264 + 8 * hh + 32 * 5);
            fb[3] = ldsA(buf + P4_W + (32 * 1 + r) * 264 + 8 * hh + 32 * 5);
            fb[4] = ldsA(buf + P4_W + (32 * 0 + r) * 264 + 8 * hh + 32 * 6);
            fb[5] = ldsA(buf + P4_W + (32 * 1 + r) * 264 + 8 * hh + 32 * 6);
            fb[6] = ldsA(buf + P4_W + (32 * 0 + r) * 264 + 8 * hh + 32 * 7);
            fb[7] = ldsA(buf + P4_W + (32 * 1 + r) * 264 + 8 * hh + 32 * 7);
            __builtin_amdgcn_sched_barrier(0);
            vn[0] = MFMA32(fa[0], Sb[0], vn[0]);
            vn[1] = MFMA32(fa[1], Sb[0], vn[1]);
            vn[0] = MFMA32(fa[2], Sb[1], vn[0]);
            vn[1] = MFMA32(fa[3], Sb[1], vn[1]);
            vn[0] = MFMA32(fa[4], Sb[2], vn[0]);
            vn[1] = MFMA32(fa[5], Sb[2], vn[1]);
            vn[0] = MFMA32(fa[6], Sb[3], vn[0]);
            vn[1] = MFMA32(fa[7], Sb[3], vn[1]);
            __builtin_amdgcn_sched_barrier(0);
            fa[0] = ldsA(buf + P4_QD + (32 * 0 + r) * 264 + 8 * hh + 32 * 0);
            fa[1] = ldsA(buf + P4_QD + (32 * 1 + r) * 264 + 8 * hh + 32 * 0);
            fa[2] = ldsA(buf + P4_QD + (32 * 0 + r) * 264 + 8 * hh + 32 * 1);
            fa[3] = ldsA(buf + P4_QD + (32 * 1 + r) * 264 + 8 * hh + 32 * 1);
            fa[4] = ldsA(buf + P4_QD + (32 * 0 + r) * 264 + 8 * hh + 32 * 2);
            fa[5] = ldsA(buf + P4_QD + (32 * 1 + r) * 264 + 8 * hh + 32 * 2);
            fa[6] = ldsA(buf + P4_QD + (32 * 0 + r) * 264 + 8 * hh + 32 * 3);
            fa[7] = ldsA(buf + P4_QD + (32 * 1 + r) * 264 + 8 * hh + 32 * 3);
            __builtin_amdgcn_sched_barrier(0);
            vn[0] = MFMA32(fb[0], Sb[4], vn[0]);
            vn[1] = MFMA32(fb[1], Sb[4], vn[1]);
            vn[0] = MFMA32(fb[2], Sb[5], vn[0]);
            vn[1] = MFMA32(fb[3], Sb[5], vn[1]);
            vn[0] = MFMA32(fb[4], Sb[6], vn[0]);
            vn[1] = MFMA32(fb[5], Sb[6], vn[1]);
            vn[0] = MFMA32(fb[6], Sb[7], vn[0]);
            vn[1] = MFMA32(fb[7], Sb[7], vn[1]);
            __builtin_amdgcn_sched_barrier(0);
            fb[0] = ldsA(buf + P4_QD + (32 * 0 + r) * 264 + 8 * hh + 32 * 4);
            fb[1] = ldsA(buf + P4_QD + (32 * 1 + r) * 264 + 8 * hh + 32 * 4);
            fb[2] = ldsA(buf + P4_QD + (32 * 0 + r) * 264 + 8 * hh + 32 * 5);
            fb[3] = ldsA(buf + P4_QD + (32 * 1 + r) * 264 + 8 * hh + 32 * 5);
            fb[4] = ldsA(buf + P4_QD + (32 * 0 + r) * 264 + 8 * hh + 32 * 6);
            fb[5] = ldsA(buf + P4_QD + (32 * 1 + r) * 264 + 8 * hh + 32 * 6);
            fb[6] = ldsA(buf + P4_QD + (32 * 0 + r) * 264 + 8 * hh + 32 * 7);
            fb[7] = ldsA(buf + P4_QD + (32 * 1 + r) * 264 + 8 * hh + 32 * 7);
            __builtin_amdgcn_sched_barrier(0);
            o[0] = MFMA32(fa[0], Sb[0], o[0]);
            o[1] = MFMA32(fa[1], Sb[0], o[1]);
            o[0] = MFMA32(fa[2], Sb[1], o[0]);
            o[1] = MFMA32(fa[3], Sb[1], o[1]);
            o[0] = MFMA32(fa[4], Sb[2], o[0]);
            o[1] = MFMA32(fa[5], Sb[2], o[1]);
            o[0] = MFMA32(fa[6], Sb[3], o[0]);
            o[1] = MFMA32(fa[7], Sb[3], o[1]);
            { _Pragma("unroll") for (int q = 0; q < 4; ++q) vb[q] = packf(vn[q >> 1], q & 1); }
            __builtin_amdgcn_sched_barrier(0);
            fa[0] = ldsA(buf + P4_QK + (32 * 0 + r) * 136 + 8 * hh + 32 * 0);
            fa[1] = ldsA(buf + P4_QK + (32 * 1 + r) * 136 + 8 * hh + 32 * 0);
            fa[2] = ldsA(buf + P4_QK + (32 * 0 + r) * 136 + 8 * hh + 32 * 1);
            fa[3] = ldsA(buf + P4_QK + (32 * 1 + r) * 136 + 8 * hh + 32 * 1);
            fa[4] = ldsA(buf + P4_QK + (32 * 0 + r) * 136 + 8 * hh + 32 * 2);
            fa[5] = ldsA(buf + P4_QK + (32 * 1 + r) * 136 + 8 * hh + 32 * 2);
            fa[6] = ldsA(buf + P4_QK + (32 * 0 + r) * 136 + 8 * hh + 32 * 3);
            fa[7] = ldsA(buf + P4_QK + (32 * 1 + r) * 136 + 8 * hh + 32 * 3);
            __builtin_amdgcn_sched_barrier(0);
            o[0] = MFMA32(fb[0], Sb[4], o[0]);
            o[1] = MFMA32(fb[1], Sb[4], o[1]);
            o[0] = MFMA32(fb[2], Sb[5], o[0]);
            o[1] = MFMA32(fb[3], Sb[5], o[1]);
            o[0] = MFMA32(fb[4], Sb[6], o[0]);
            o[1] = MFMA32(fb[5], Sb[6], o[1]);
            o[0] = MFMA32(fb[6], Sb[7], o[0]);
            o[1] = MFMA32(fb[7], Sb[7], o[1]);
            { _Pragma("unroll") for (int ms = 0; ms < 4; ++ms) _Pragma("unroll") for (int i = 0; i < 16; ++i) S[ms][i] *= dec; }
            __builtin_amdgcn_sched_barrier(0);
            fb[0] = ldsA(buf + P4_KDT + (32 * 0 + r) * 136 + 8 * hh + 32 * 0);
            fb[1] = ldsA(buf + P4_KDT + (32 * 1 + r) * 136 + 8 * hh + 32 * 0);
            fb[2] = ldsA(buf + P4_KDT + (32 * 2 + r) * 136 + 8 * hh + 32 * 0);
            fb[3] = ldsA(buf + P4_KDT + (32 * 3 + r) * 136 + 8 * hh + 32 * 0);
            fb[4] = ldsA(buf + P4_KDT + (32 * 0 + r) * 136 + 8 * hh + 32 * 1);
            fb[5] = ldsA(buf + P4_KDT + (32 * 1 + r) * 136 + 8 * hh + 32 * 1);
            fb[6] = ldsA(buf + P4_KDT + (32 * 2 + r) * 136 + 8 * hh + 32 * 1);
            fb[7] = ldsA(buf + P4_KDT + (32 * 3 + r) * 136 + 8 * hh + 32 * 1);
            __builtin_amdgcn_sched_barrier(0);
            o[0] = MFMA32(fa[0], vb[0], o[0]);
            o[1] = MFMA32(fa[1], vb[0], o[1]);
            o[0] = MFMA32(fa[2], vb[1], o[0]);
            o[1] = MFMA32(fa[3], vb[1], o[1]);
            o[0] = MFMA32(fa[4], vb[2], o[0]);
            o[1] = MFMA32(fa[5], vb[2], o[1]);
            o[0] = MFMA32(fa[6], vb[3], o[0]);
            o[1] = MFMA32(fa[7], vb[3], o[1]);
            __builtin_amdgcn_sched_barrier(0);
            fa[0] = ldsA(buf + P4_KDT + (32 * 0 + r) * 136 + 8 * hh + 32 * 2);
            fa[1] = ldsA(buf + P4_KDT + (32 * 1 + r) * 136 + 8 * hh + 32 * 2);
            fa[2] = ldsA(buf + P4_KDT + (32 * 2 + r) * 136 + 8 * hh + 32 * 2);
            fa[3] = ldsA(buf + P4_KDT + (32 * 3 + r) * 136 + 8 * hh + 32 * 2);
            fa[4] = ldsA(buf + P4_KDT + (32 * 0 + r) * 136 + 8 * hh + 32 * 3);
            fa[5] = ldsA(buf + P4_KDT + (32 * 1 + r) * 136 + 8 * hh + 32 * 3);
            fa[6] = ldsA(buf + P4_KDT + (32 * 2 + r) * 136 + 8 * hh + 32 * 3);
            fa[7] = ldsA(buf + P4_KDT + (32 * 3 + r) * 136 + 8 * hh + 32 * 3);
            __builtin_amdgcn_sched_barrier(0);
            S[0] = MFMA32(fb[0], vb[0], S[0]);
            S[1] = MFMA32(fb[1], vb[0], S[1]);
            S[2] = MFMA32(fb[2], vb[0], S[2]);
            S[3] = MFMA32(fb[3], vb[0], S[3]);
            S[0] = MFMA32(fb[4], vb[1], S[0]);
            S[1] = MFMA32(fb[5], vb[1], S[1]);
            S[2] = MFMA32(fb[6], vb[1], S[2]);
            S[3] = MFMA32(fb[7], vb[1], S[3]);
            if (g >= 4 && !dry) {
                bf16_t* op = Ug + idx * 8192 + (size_t)(((2 * dvh + wid) * 2) * 64 + lane) * 16;
#pragma unroll
                for (int mt = 0; mt < 2; ++mt) {
                    u32x4 w0, w1;
                    w0.x = pk2(o[mt][0], o[mt][1]); w0.y = pk2(o[mt][2], o[mt][3]); w0.z = pk2(o[mt][4], o[mt][5]); w0.w = pk2(o[mt][6], o[mt][7]);
                    w1.x = pk2(o[mt][8], o[mt][9]); w1.y = pk2(o[mt][10], o[mt][11]); w1.z = pk2(o[mt][12], o[mt][13]); w1.w = pk2(o[mt][14], o[mt][15]);
                    *(u32x4*)(op + mt * 1024) = w0; *(u32x4*)(op + mt * 1024 + 8) = w1;
                }
            }
            __builtin_amdgcn_sched_barrier(0);
            __builtin_amdgcn_sched_barrier(0);
            S[0] = MFMA32(fa[0], vb[2], S[0]);
            S[1] = MFMA32(fa[1], vb[2], S[1]);
            S[2] = MFMA32(fa[2], vb[2], S[2]);
            S[3] = MFMA32(fa[3], vb[2], S[3]);
            S[0] = MFMA32(fa[4], vb[3], S[0]);
            S[1] = MFMA32(fa[5], vb[3], S[1]);
            S[2] = MFMA32(fa[6], vb[3], S[2]);
            S[3] = MFMA32(fa[7], vb[3], S[3]);
            __builtin_amdgcn_sched_barrier(0);
        }
        lbar();
    }
}

DI void phase_y(const Params& p, LAS unsigned char* lds, const bool dry) {
    const int tid = threadIdx.x;
    unsigned char* ws = p.ws;
    const bf16_t* Ug = (const bf16_t*)(ws + WS_U);
    bf16_t* ZA = (bf16_t*)(ws + WS_Q);
    const float* onw = p.in[11];
    LAS float* Os = (LAS float*)lds;
    const int w = tid >> 7, mt = (tid >> 6) & 1, lane = tid & 63, r = lane & 31, hh = lane >> 5;
    const int tok = tid >> 3, c8 = tid & 7;
    float wn[16];
#pragma unroll
    for (int e = 0; e < 16; ++e) wn[e] = onw[c8 * 16 + e];
    u32x4 fa0, fa1, fb0, fb1, z0, z1;
    auto loaditem = [&](int it) {
        const int b = it >> 9, h = (it >> 6) & 7, n = it & 63;
        const size_t idx0 = (size_t)((b * 8 + h) * 2 + 0) * NCHUNK + 4 + n, idx1 = (size_t)((b * 8 + h) * 2 + 1) * NCHUNK + 4 + n;
        fa0 = ld_nt((const u32x4*)(Ug + idx0 * 8192 + (size_t)tid * 16)); fa1 = ld_nt((const u32x4*)(Ug + idx0 * 8192 + (size_t)tid * 16 + 8));
        fb0 = ld_nt((const u32x4*)(Ug + idx1 * 8192 + (size_t)tid * 16)); fb1 = ld_nt((const u32x4*)(Ug + idx1 * 8192 + (size_t)tid * 16 + 8));
        const bf16_t* zp = ZA + ((size_t)b * 4096 + n * 64 + tok) * 1024 + h * 128 + c8 * 16;
        z0 = ld_nt((const u32x4*)zp); z1 = ld_nt((const u32x4*)(zp + 8));
    };
    if (blockIdx.x < 4096) loaditem(blockIdx.x);
    for (int it = blockIdx.x; it < 4096; it += gridDim.x) {
        const int b = it >> 9, h = (it >> 6) & 7, n = it & 63;
        const unsigned ua[8] = {fa0.x, fa0.y, fa0.z, fa0.w, fa1.x, fa1.y, fa1.z, fa1.w};
        const unsigned ub[8] = {fb0.x, fb0.y, fb0.z, fb0.w, fb1.x, fb1.y, fb1.z, fb1.w};
        const unsigned zz[8] = {z0.x, z0.y, z0.z, z0.w, z1.x, z1.y, z1.z, z1.w};
        if (it + (int)gridDim.x < 4096) loaditem(it + gridDim.x);
#pragma unroll
        for (int e = 0; e < 8; ++e) {
            Os[(32 * mt + crow(2 * e, hh)) * 129 + 32 * w + r] = bflo(ua[e]);
            Os[(32 * mt + crow(2 * e + 1, hh)) * 129 + 32 * w + r] = bfhi(ua[e]);
        }
        lbar();
#pragma unroll
        for (int e = 0; e < 8; ++e) {
            Os[(63 - (32 * mt + crow(2 * e, hh))) * 129 + 32 * w + r] += bflo(ub[e]);
            Os[(63 - (32 * mt + crow(2 * e + 1, hh))) * 129 + 32 * w + r] += bfhi(ub[e]);
        }
        lbar();
        {
            float o[16]; float ss = 0.f;
#pragma unroll
            for (int e = 0; e < 16; ++e) { o[e] = Os[tok * 129 + c8 * 16 + e]; ss += o[e] * o[e]; }
            ss += __shfl_xor(ss, 1); ss += __shfl_xor(ss, 2); ss += __shfl_xor(ss, 4);
            const float rstd = rsqrtf(ss * (1.f / 128.f) + 1e-6f);
            bf16_t* zp = ZA + ((size_t)b * 4096 + n * 64 + tok) * 1024 + h * 128 + c8 * 16;
            unsigned res[8];
#pragma unroll
            for (int e = 0; e < 8; ++e) {
                const float y0 = o[2 * e] * rstd * wn[2 * e] * bflo(zz[e]);
                const float y1 = o[2 * e + 1] * rstd * wn[2 * e + 1] * bfhi(zz[e]);
                res[e] = pk2(y0, y1);
            }
            u32x4 w0 = {res[0], res[1], res[2], res[3]}, w1 = {res[4], res[5], res[6], res[7]};
            if (!dry) { *(u32x4*)zp = w0; *(u32x4*)(zp + 8) = w1; }
        }
        lbar();
    }
}

DI void phase_final_ln(const Params& p, const bool dry) {
    const int lane = threadIdx.x & 63, wid = threadIdx.x >> 6;
    const float* lg = p.in[17]; const float* lb = p.in[18]; const float* x = p.in[0];
    const float* MOD = (const float*)(p.ws + WS_MOD);
    const bf16_t* Y = (const bf16_t*)(p.ws + WS_Q);
    const int stride = gridDim.x * 8;
    int row = blockIdx.x * 8 + wid;
    f32x4 xv[4], nx[4], gv[4], bv[4]; u32x2 yv[4], ny[4];
#pragma unroll
    for (int i = 0; i < 4; ++i) { gv[i] = *(const f32x4*)(lg + i * 256 + lane * 4); bv[i] = *(const f32x4*)(lb + i * 256 + lane * 4); }
    if (row < XR) {
#pragma unroll
        for (int i = 0; i < 4; ++i) { xv[i] = ld_nt((const f32x4*)(x + (size_t)row * 1024 + i * 256 + lane * 4)); yv[i] = ld_nt((const u32x2*)(Y + (size_t)row * 1024 + i * 256 + lane * 4)); }
    }
    for (; row < XR; row += stride) {
        if (row + stride < XR) {
#pragma unroll
            for (int i = 0; i < 4; ++i) { nx[i] = ld_nt((const f32x4*)(x + (size_t)(row + stride) * 1024 + i * 256 + lane * 4)); ny[i] = ld_nt((const u32x2*)(Y + (size_t)(row + stride) * 1024 + i * 256 + lane * 4)); }
        }
        const float* gate = MOD + (row >> 12) * 3072 + 2048;
        f32x4 z[4];
#pragma unroll
        for (int i = 0; i < 4; ++i) {
            const f32x4 gt = *(const f32x4*)(gate + i * 256 + lane * 4);
            z[i][0] = xv[i][0] * DN_ALPHA + gt[0] * bflo(yv[i].x); z[i][1] = xv[i][1] * DN_ALPHA + gt[1] * bfhi(yv[i].x);
            z[i][2] = xv[i][2] * DN_ALPHA + gt[2] * bflo(yv[i].y); z[i][3] = xv[i][3] * DN_ALPHA + gt[3] * bfhi(yv[i].y);
        }
        float s = 0.f;
#pragma unroll
        for (int i = 0; i < 4; ++i) s += z[i][0] + z[i][1] + z[i][2] + z[i][3];
#pragma unroll
        for (int o = 1; o < 64; o <<= 1) s += __shfl_xor(s, o);
        const float mu = s * (1.f / 1024.f);
        float q = 0.f;
#pragma unroll
        for (int i = 0; i < 4; ++i)
#pragma unroll
            for (int j = 0; j < 4; ++j) { const float dd = z[i][j] - mu; q += dd * dd; }
#pragma unroll
        for (int o = 1; o < 64; o <<= 1) q += __shfl_xor(q, o);
        const float rstd = rsqrtf(q * (1.f / 1024.f) + 1e-5f);
#pragma unroll
        for (int i = 0; i < 4; ++i) {
            f32x4 y;
#pragma unroll
            for (int j = 0; j < 4; ++j) y[j] = (z[i][j] - mu) * rstd * gv[i][j] + bv[i][j];
            if (!dry) *(f32x4*)(p.out + (size_t)row * 1024 + i * 256 + lane * 4) = y;
        }
#pragma unroll
        for (int i = 0; i < 4; ++i) { xv[i] = nx[i]; yv[i] = ny[i]; }
    }
}

__global__ void __launch_bounds__(NTHR, 2) fwd_megakernel(Params p) {
    extern __shared__ __attribute__((aligned(16))) unsigned char smem[];
    LAS unsigned char* lds = (LAS unsigned char*)smem;
    unsigned char* ws = p.ws;
    const int lo = p.ph_lo, hi = p.ph_hi;
#define IN(k) (lo <= (k) && (k) < hi)
#define SEAM(k) do { if (IN(k) && IN((k) + 1)) xcd_barrier(xbar); } while (0)
    if (p.ph_hi == 77) cg::this_grid().sync();
    volatile LAS unsigned* xst = (volatile LAS unsigned*)(lds + SMEM_XB);
    if (threadIdx.x == 0) { xst[0] = 0u; xst[1] = 0u; }
    __syncthreads();
    XcdBarrier xbar; xbar.bar = (unsigned*)(ws + WS_BAR); xbar.x = 0; xbar.st = xst;
    if (hi - lo > 1) xbar = xcd_barrier_post((unsigned*)(ws + WS_BAR), xst);
    const bool dryrt = (p.ph_hi != 77);
    const float* BP = (const float*)(ws + WS_BIASP);
    if (PROBE_DUP == 0 && IN(0)) { phase0(p, lds); xcd_barrier(xbar); }
    if (IN(0)) phase0(p, lds);
    SEAM(0);
    if (PROBE_DUP == 1 && IN(1)) { phase_ln_mod(p); xcd_barrier(xbar); }
    if (IN(1)) phase_ln_mod(p);
    SEAM(1);
    for (int rep = (PROBE_DUP == 2 ? 0 : 1); rep < 2; ++rep) { if (rep == 0) { } else if (PROBE_DUP == 2) xcd_barrier(xbar);
    if (IN(2)) {
        pg8::Gemm g{(const bf16_t*)(ws + WS_QKHX), (const bf16_t*)(ws + WS_WINT), ROWS, 13 * 256, 1024};
        pg8::StaticOrder S; S.init(ROWS, 13 * 256, gridDim.x, blockIdx.x);
        static_assert(WS_V - WS_K == WS_K - WS_Q, "q|k|v buffers equally spaced");
        EpiQKV E{(bf16_t*)(ws + WS_Q), (float*)(ws + WS_AB), BP};
        pg8::gemm_phase(lds, g, S, E);
    }
    }
    SEAM(2);
    if (PROBE_DUP == 3 && IN(3)) { phase_gdn_pre(p, lds, dryrt); xcd_barrier(xbar); }
    if (IN(3)) phase_gdn_pre(p, lds, false);
    SEAM(3);
    if (PROBE_DUP == 4 && IN(4)) { phase_gdn_scan(p, lds, dryrt); xcd_barrier(xbar); }
    if (IN(4)) phase_gdn_scan(p, lds, false);
    SEAM(4);
    for (int rep = (PROBE_DUP == 6 ? 0 : 1); rep < 2; ++rep) { if (rep == 0) { } else if (PROBE_DUP == 6) xcd_barrier(xbar);
    if (IN(6)) {
        pg8::Gemm g{(const bf16_t*)(ws + WS_QKHX), (const bf16_t*)(ws + WS_WINT) + (size_t)13 * 256 * 1024, XR, 28 * 256, 1024};
        pg8::StaticOrder S; S.init(XR, 28 * 256, gridDim.x, blockIdx.x);
        EpiRest E{(bf16_t*)(ws + WS_Q), (bf16_t*)(ws + WS_V), (bf16_t*)p.out, (bf16_t*)p.out + (size_t)XR * 1024, BP + 13 * 256, p.in[12], p.in[13]};
        pg8::gemm_phase(lds, g, S, E);
    }
    }
    SEAM(6);
    if (PROBE_DUP == 7 && IN(7)) { phase_y(p, lds, dryrt); xcd_barrier(xbar); }
    if (IN(7)) phase_y(p, lds, false);
    SEAM(7);
    for (int rep = (PROBE_DUP == 8 ? 0 : 1); rep < 2; ++rep) { if (rep == 0) { } else if (PROBE_DUP == 8) xcd_barrier(xbar);
    if (IN(8)) {
        static_assert(WS_V - WS_Q == (size_t)EpiMergePair::DPM * 256 * 1024 * 2 && WS_WBT - WS_WAT == (size_t)EpiMergePair::DPN * 256 * 1024 * 2, "pair offsets");
        pg8::PairOrder S; S.S.init(XR, 1024, gridDim.x, blockIdx.x); S.dpm = EpiMergePair::DPM; S.dpn = EpiMergePair::DPN;
        pg8::Gemm g{(const bf16_t*)(ws + WS_Q), (const bf16_t*)(ws + WS_WAT), XR, 1024, 1024};
        EpiMergePair E{(bf16_t*)(ws + WS_QKHX), (const bf16_t*)p.out, (const bf16_t*)p.out + (size_t)XR * 1024};
        pg8::gemm_phase(lds, g, S, E);
    }
    }
    SEAM(8);
    for (int rep = (PROBE_DUP == 9 ? 0 : 1); rep < 2; ++rep) { if (rep == 0) { } else if (PROBE_DUP == 9) xcd_barrier(xbar);
    if (IN(9)) {
        pg8::Gemm g{(const bf16_t*)(ws + WS_QKHX), (const bf16_t*)(ws + WS_WOT), XR, 1024, 1024};
        pg8::StaticOrder S; S.init(XR, 1024, gridDim.x, blockIdx.x);
        EpiOut E{(bf16_t*)(ws + WS_Q)};
        pg8::gemm_phase(lds, g, S, E);
    }
    }
    SEAM(9);
    if (PROBE_DUP == 10 && IN(10)) { phase_final_ln(p, dryrt); xcd_barrier(xbar); }
    if (IN(10)) phase_final_ln(p, false);
#undef IN
#undef SEAM
}

constexpr int N_PHASES = 11;

extern "C" void kernel_launch(void* const* d_in, const int* in_sizes, int n_in, void* d_out, int out_size, void* d_ws, size_t ws_size, hipStream_t stream) {
    static int grid = 0;
    if (grid == 0) {
        if (n_in != 19 || out_size != XR * DM || ws_size < WS_END) { fprintf(stderr, "kernel_launch: unexpected shapes / workspace (%d inputs, out %d, ws %zu < %zu)\n", n_in, out_size, ws_size, (size_t)WS_END); grid = -1; return; }
        int dev = 0, cus = 0, per_cu = 0;
        hipGetDevice(&dev);
        hipDeviceGetAttribute(&cus, hipDeviceAttributeMultiprocessorCount, dev);
        if (hipFuncSetAttribute((const void*)fwd_megakernel, hipFuncAttributeMaxDynamicSharedMemorySize, SMEM_BYTES) != hipSuccess) { fprintf(stderr, "kernel_launch: hipFuncSetAttribute failed\n"); grid = -1; return; }
        hipOccupancyMaxActiveBlocksPerMultiprocessor(&per_cu, (const void*)fwd_megakernel, NTHR, SMEM_BYTES);
        if (per_cu < 1) per_cu = 1;
        grid = cus * per_cu;
        if (grid > 256) grid = 256;
        (void)hipGetLastError();
    }
    if (grid < 0) return;
    if (hipMemsetAsync((char*)d_ws + WS_BAR, 0, (size_t)XCD_BAR_WORDS_C * 4, stream) != hipSuccess) { fprintf(stderr, "kernel_launch: memset of barrier words failed\n"); return; }
    Params p{};
    for (int i = 0; i < 19; ++i) p.in[i] = (const float*)d_in[i];
    p.out = (float*)d_out; p.ws = (unsigned char*)d_ws;
#if MK_MULTI
    for (int k = 0; k < N_PHASES; ++k) {
        p.ph_lo = k; p.ph_hi = k + 1;
        hipLaunchKernelGGL(fwd_megakernel, dim3(grid), dim3(NTHR), SMEM_BYTES, stream, p);
    }
#else
    p.ph_lo = 0; p.ph_hi = N_PHASES;
    void* args[] = {&p};
    hipError_t e = hipLaunchCooperativeKernel((const void*)fwd_megakernel, dim3(grid), dim3(NTHR), args, SMEM_BYTES, stream);
    if (e != hipSuccess) fprintf(stderr, "cooperative launch failed: %s (grid %d)\n", hipGetErrorString(e), grid);
#endif
}
```

```cpp
#include <hip/hip_runtime.h>
#include <hip/hip_cooperative_groups.h>
#include <cstdio>
namespace cg = cooperative_groups;

#ifndef MK_MULTI
#define MK_MULTI 0
#endif

#define DI __device__ __forceinline__
#ifndef PROBE_DUP
#define PROBE_DUP -1
#endif
#define LAS __attribute__((address_space(3)))
typedef unsigned short bf16_t;
typedef short bf16x8 __attribute__((ext_vector_type(8)));
typedef short s16x4 __attribute__((ext_vector_type(4)));
typedef float f32x2 __attribute__((ext_vector_type(2)));
typedef float f32x4 __attribute__((ext_vector_type(4)));
typedef float f32x16 __attribute__((ext_vector_type(16)));
typedef unsigned u32x2 __attribute__((ext_vector_type(2)));
typedef unsigned u32x4 __attribute__((ext_vector_type(4)));
typedef __bf16 bf16x2_t __attribute__((ext_vector_type(2)));

constexpr int DM = 1024, NB = 8, SEQ = 4096, CTXL = 256, NH = 8;
constexpr int XR = NB * SEQ;
constexpr int CR = NB * CTXL;
constexpr int ROWS = XR + CR;
constexpr int INCOLS = 10272;
constexpr int NSLOT = 41 * 256;
constexpr int NCHUNK = 68;
constexpr int NTHR = 512;
constexpr int XCD_BAR_WORDS_C = 3456;
constexpr float DN_ALPHA = 1.189207115002721f;

constexpr size_t AL(size_t x) { return (x + 255) & ~(size_t)255; }
constexpr size_t WS_WINT = 0;
constexpr size_t WS_BIASP = AL(WS_WINT + (size_t)NSLOT * 1024 * 2);
constexpr size_t WS_WAT = AL(WS_BIASP + (size_t)NSLOT * 4);
constexpr size_t WS_WBT = AL(WS_WAT + 2097152);
constexpr size_t WS_WOT = AL(WS_WBT + 2097152);
constexpr size_t WS_MOD = AL(WS_WOT + 2097152);
constexpr size_t WS_AB = AL(WS_MOD + 9 * 3072 * 4);
constexpr size_t WS_GC = AL(WS_AB + (size_t)ROWS * 32 * 4);
constexpr size_t WS_Q = AL(WS_GC + (size_t)128 * NCHUNK * 64 * 4);
constexpr size_t WS_K = AL(WS_Q + (size_t)ROWS * 1024 * 2);
constexpr size_t WS_V = AL(WS_K + (size_t)ROWS * 1024 * 2);
constexpr size_t WS_QC = AL(WS_V + (size_t)ROWS * 1024 * 2);
constexpr size_t WS_KC = AL(WS_QC + (size_t)CR * 1024 * 2);
constexpr size_t WS_U = AL(WS_KC + (size_t)CR * 1024 * 2);
constexpr size_t WS_QKHX = AL(WS_U + (size_t)128 * NCHUNK * 16384);
constexpr size_t WS_WCTX = AL(WS_QKHX + (size_t)ROWS * 1024 * 2);
constexpr size_t WS_BAR = AL(WS_WCTX + (size_t)512 * 16384);
constexpr size_t WS_END = AL(WS_BAR + (size_t)XCD_BAR_WORDS_C * 4);

constexpr int SMEM_XB = 142336;
constexpr int P3_CW = 142352;
constexpr int P3_GC2 = P3_CW + 2 * 3 * 384 * 4;
constexpr int P3_BETA2 = P3_GC2 + 1024;
constexpr int SMEM_BYTES = P3_BETA2 + 1024;

struct Params { const float* in[19]; float* out; unsigned char* ws; int ph_lo, ph_hi; };

DI unsigned pk2(float a, float b) { f32x2 v = {a, b}; bf16x2_t r = __builtin_convertvector(v, bf16x2_t); return __builtin_bit_cast(unsigned, r); }
DI float bflo(unsigned u) { return __uint_as_float(u << 16); }
DI float bfhi(unsigned u) { return __uint_as_float(u & 0xffff0000u); }
DI float bf1(bf16_t u) { return __uint_as_float(((unsigned)u) << 16); }
DI bf16_t f2bf(float a) { return (bf16_t)(pk2(a, 0.f) & 0xffffu); }
DI float sigmoidf_(float x) { return __builtin_amdgcn_rcpf(1.f + __expf(-x)); }
DI float siluf_(float x) { return x * __builtin_amdgcn_rcpf(1.f + __expf(-x)); }
DI int crow(int i, int h) { return (i & 3) + 8 * (i >> 2) + 4 * h; }
template <int CTRL> DI float dppf(float v) { return __builtin_bit_cast(float, __builtin_amdgcn_update_dpp(0, __builtin_bit_cast(int, v), CTRL, 0xF, 0xF, true)); }
DI float sum32(float v) { v += dppf<0xB1>(v); v += dppf<0x4E>(v); v += dppf<0x124>(v); v += dppf<0x128>(v); v += __shfl_xor(v, 16); return v; }
DI void lbar() { asm volatile("s_waitcnt lgkmcnt(0)\n\ts_barrier" ::: "memory"); }

DI int srccol(int slot) {
    const int tile = slot >> 8, w = slot & 255;
    const int g = w >> 5, n = (w >> 4) & 1, fq = (w >> 2) & 3, j = w & 3;
    const int lc = 32 * g + 8 * fq + 4 * n + j;
    if (tile < 12) return tile * 256 + lc;
    if (tile == 12) return (w < 32) ? 4096 + lc : -1;
    if (tile < 17) return 3072 + (tile - 13) * 256 + lc;
    const int tb = tile - 17;
    if (tb < 16) {
        const int bj = w >> 7, wc2 = (w >> 5) & 3;
        const int ch = 64 * tb + 16 * wc2 + 4 * fq + j;
        return (bj == 0 ? (n ? 6176 : 4128) : (n ? 7200 : 5152)) + ch;
    }
    const int ch = (tb - 16) * 128 + 32 * ((w >> 5) & 3) + 8 * fq + 4 * n + j;
    return ((w >> 7) ? 9248 : 8224) + ch;
}
DI int plaincol(int s) { return (s & ~31) + 8 * ((s >> 2) & 3) + 4 * ((s >> 4) & 1) + (s & 3); }


#define XB_TMO      128
#define XB_XCNT(j)  (256  + 64 * (j))
#define XB_XSUB(j)  (1280 + 64 * (j))
#define XB_XGEN(j)  (2304 + 64 * (j))
#define XB_TOP      3328
#define XB_TOPGEN   3392
#define XCD_BAR_WORDS 3456
#define XB_SPIN_CAP (1u << 18)
DI unsigned xb_ld(unsigned* p) { return __hip_atomic_load(p, __ATOMIC_RELAXED, __HIP_MEMORY_SCOPE_AGENT); }
DI unsigned xb_add(unsigned* p, unsigned v) { return __hip_atomic_fetch_add(p, v, __ATOMIC_RELAXED, __HIP_MEMORY_SCOPE_AGENT); }
DI unsigned xb_xcc_id() { return (unsigned)__builtin_amdgcn_s_getreg((3 << 11) | 20) & 0xFu; }
#define XB_SPIN(cond, bar) do { unsigned _sp = 0; while (cond) { __builtin_amdgcn_s_sleep(1); \
    if ((++_sp & 255u) == 0u) { if (xb_ld(&(bar)[XB_TMO])) break; if (_sp > XB_SPIN_CAP) { atomicAdd(&(bar)[XB_TMO], 1u); break; } } } } while (0)
struct XcdBarrier { unsigned* bar; unsigned x; volatile LAS unsigned* st; };
DI XcdBarrier xcd_barrier_post(unsigned* bar, volatile LAS unsigned* st) {
    XcdBarrier b; b.bar = bar; b.x = xb_xcc_id(); b.st = st;
    if (threadIdx.x == 0) (void)xb_add(&bar[XB_XCNT(b.x)], 1u);
    return b;
}
DI void xcd_barrier_complete(unsigned* bar, unsigned x, unsigned& nloc, unsigned& nx) {
    const unsigned G = gridDim.x * gridDim.y * gridDim.z;
    unsigned sum, cnt, mine, sp = 0u;
    for (;;) {
        sum = 0u; cnt = 0u; mine = 0u;
#pragma unroll
        for (unsigned j = 0; j < 16; ++j) { const unsigned c = xb_ld(&bar[XB_XCNT(j)]); sum += c; cnt += (c > 0u) ? 1u : 0u; mine = (j == x) ? c : mine; }
        if (sum == G) break;
        __builtin_amdgcn_s_sleep(1);
        if ((++sp & 255u) == 0u) { if (xb_ld(&bar[XB_TMO])) break; if (sp > XB_SPIN_CAP) { atomicAdd(&bar[XB_TMO], 1u); break; } }
    }
    nloc = mine > 0u ? mine : 1u; nx = cnt > 0u ? cnt : 1u;
}
DI void xcd_barrier(const XcdBarrier& b) {
    asm volatile("s_waitcnt vmcnt(0)" ::: "memory");
    __syncthreads();
    if (threadIdx.x == 0) {
        unsigned* bar = b.bar;
        __builtin_amdgcn_s_waitcnt(0);
        unsigned nloc = b.st[0], nx = b.st[1];
        if (nloc == 0u) { xcd_barrier_complete(bar, b.x, nloc, nx); b.st[0] = nloc; b.st[1] = nx; }
        const unsigned old = xb_add(&bar[XB_XSUB(b.x)], 1u);
        const unsigned gen = old / nloc;
        if (old + 1u == (gen + 1u) * nloc) {
            __builtin_amdgcn_fence(__ATOMIC_RELEASE, "agent");
            asm volatile("s_waitcnt vmcnt(0)" ::: "memory");
            const unsigned og = xb_add(&bar[XB_TOP], 1u);
            const unsigned tg = og / nx;
            if (og + 1u == (tg + 1u) * nx) xb_add(&bar[XB_TOPGEN], 1u);
            else XB_SPIN(xb_ld(&bar[XB_TOPGEN]) == tg, bar);
            __builtin_amdgcn_fence(__ATOMIC_ACQUIRE, "agent");
            xb_add(&bar[XB_XGEN(b.x)], 1u);
            asm volatile("s_waitcnt vmcnt(0)" ::: "memory");
        } else {
            XB_SPIN(xb_ld(&bar[XB_XGEN(b.x)]) == gen, bar);
            __builtin_amdgcn_fence(__ATOMIC_ACQUIRE, "agent");
            asm volatile("s_waitcnt vmcnt(0)" ::: "memory");
        }
    }
    __syncthreads();
}

namespace pg8 {
constexpr int BM = 256, BK = 64, HALF = 128, HTB = HALF * BK * 2, STAGE_BYTES = 8 * HTB, NXCD = 8, WGM = 8;
DI int lds_byte(int r, int c) { const int st = (r >> 4) * 2 + (c >> 5), rr = r & 15, cc = c & 31, ob = rr * 64 + cc * 2; return st * 1024 + (ob ^ (((ob >> 9) & 1) << 5)); }
DI void stage_rc(int b, int& R, int& C) { const int st = b / 1024, sb = b % 1024, swz = sb ^ (((sb >> 9) & 1) << 5); R = (st >> 1) * 16 + swz / 64; C = (st & 1) * 32 + (swz % 64) / 2; }
struct Unit { int pm, pn; };
struct Gemm { const bf16_t* A; const bf16_t* Bt; int M, N, K; };
struct StaticOrder {
    int nM, nN, nwg, G, c;
    DI void init(int M, int N, int G_, int c_) { nM = M / BM; nN = N / BM; nwg = nM * nN; G = G_; c = c_; }
    DI bool next(int i, Unit& u) const {
        const long L = (long)i * G + c; if (L >= nwg) return false;
        int wgid = (int)L; { const int q = nwg / NXCD, r = nwg % NXCD, xcd = wgid % NXCD, off = wgid / NXCD; wgid = (xcd < r ? xcd * (q + 1) : r * (q + 1) + (xcd - r) * q) + off; }
        const int nig = WGM * nN, gid = wgid / nig, fm = gid * WGM, gsz = (nM - fm) < WGM ? (nM - fm) : WGM;
        u.pm = fm + ((wgid % nig) % gsz); u.pn = (wgid % nig) / gsz; return true;
    }
};

struct PairOrder {
    StaticOrder S; int dpm, dpn;
    DI bool next(int i, Unit& u) const { if (!S.next(i >> 1, u)) return false; if (i & 1) { u.pm += dpm; u.pn += dpn; } return true; }
};
template <class Epi, class Sched>
DI void gemm_phase(LAS unsigned char* lds, const Gemm g, const Sched& S, const Epi& E) {
    int tid_ = threadIdx.x; asm volatile("" : "+v"(tid_));
    const int tid = tid_, wid = __builtin_amdgcn_readfirstlane(tid >> 6), lane = tid & 63, wr = wid >> 2, wc = wid & 3, fr = lane & 15, fq = lane >> 4;
    const int K = g.K, nt = K / BK;
    unsigned voffA[2];
#pragma unroll
    for (int i = 0; i < 2; ++i) { int R, C; stage_rc(tid * 16 + i * 8192, R, C); voffA[i] = (unsigned)(R * K + C) * 2u; }
    const size_t kstep = (size_t)(BK * 2);
    const size_t hstep = (size_t)HALF * K * 2;
    const size_t tstep = 2 * hstep;
    const unsigned ldsw = (unsigned)wid * 1024u;
    const int aoff = lds_byte(wr * 64 + fr, fq * 8), boff = lds_byte(wc * 32 + fr, fq * 8);
#define PG8_SA(b, h) (((b) * 2 + (h)) * HTB)
#define PG8_SB(b, h) ((4 + (b) * 2 + (h)) * HTB)
#define PG8_STAGE(bufoff, gbase) do { _Pragma("unroll") for (int _i = 0; _i < 2; ++_i) \
        __builtin_amdgcn_global_load_lds((const unsigned*)((const char*)(gbase) + voffA[_i]), (LAS unsigned*)(lds + (bufoff) + ldsw + _i * 8192), 16, 0, 0); } while (0)
#define PG8_LDA(dst, b, h) do { _Pragma("unroll") for (int m = 0; m < 4; ++m) _Pragma("unroll") for (int k = 0; k < 2; ++k) dst[m][k] = *(const LAS bf16x8*)(lds + PG8_SA(b, h) + aoff + m * 2048 + k * 1024); } while (0)
#define PG8_LDB(dst, b, h) do { _Pragma("unroll") for (int n = 0; n < 2; ++n) _Pragma("unroll") for (int k = 0; k < 2; ++k) dst[n][k] = *(const LAS bf16x8*)(lds + PG8_SB(b, h) + boff + n * 2048 + k * 1024); } while (0)
#define PG8_MMA(ai, bj, At, Bt) do { __builtin_amdgcn_s_setprio(1); _Pragma("unroll") for (int m = 0; m < 4; ++m) _Pragma("unroll") for (int n = 0; n < 2; ++n) _Pragma("unroll") for (int k = 0; k < 2; ++k) \
        acc[ai][bj][m][n] = __builtin_amdgcn_mfma_f32_16x16x32_bf16(Bt[n][k], At[m][k], acc[ai][bj][m][n], 0, 0, 0); __builtin_amdgcn_s_setprio(0); } while (0)
#define PG8_WAIT_V(n) asm volatile("s_waitcnt vmcnt(" #n ")" ::: "memory")
#define PG8_WAIT_L(n) asm volatile("s_waitcnt lgkmcnt(" #n ")" ::: "memory")
#define PG8_BAR __builtin_amdgcn_s_barrier()
#define PG8_SCHED __builtin_amdgcn_sched_barrier(0)
    Unit cur, nxt; int ui = 0;
    if (!S.next(0, cur)) return;
    f32x4 acc[2][2][4][2];
#pragma unroll
    for (int a = 0; a < 2; ++a)
#pragma unroll
        for (int b = 0; b < 2; ++b)
#pragma unroll
            for (int m = 0; m < 4; ++m)
#pragma unroll
                for (int n = 0; n < 2; ++n) acc[a][b][m][n] = (f32x4){0.f, 0.f, 0.f, 0.f};
    bf16x8 At[4][2], B0[2][2], B1[2][2];
    const char* cA = (const char*)g.A + (size_t)cur.pm * tstep; const char* cB = (const char*)g.Bt + (size_t)cur.pn * tstep;
    PG8_STAGE(PG8_SB(0, 0), cB); PG8_STAGE(PG8_SB(0, 1), cB + hstep); PG8_STAGE(PG8_SA(0, 0), cA); PG8_STAGE(PG8_SA(0, 1), cA + hstep);
    if (wr == 1) PG8_BAR;
    PG8_WAIT_V(2); PG8_BAR;
    PG8_STAGE(PG8_SB(1, 0), cB + kstep); PG8_STAGE(PG8_SA(1, 0), cA + kstep); PG8_STAGE(PG8_SB(1, 1), cB + hstep + kstep);
    PG8_WAIT_V(6); PG8_BAR;
    for (;;) {
        const bool has_next = S.next(ui + 1, nxt);
        const char* nA = has_next ? (const char*)g.A + (size_t)nxt.pm * tstep : cA; const char* nB = has_next ? (const char*)g.Bt + (size_t)nxt.pn * tstep : cB;
        for (int t = 0; t < nt; t += 2) {
            const bool last = (t == nt - 2);
            const char* a1 = cA + (size_t)(t + 1) * kstep;
            const char* a2 = last ? nA : cA + (size_t)(t + 2) * kstep; const char* b2 = last ? nB : cB + (size_t)(t + 2) * kstep;
            const char* a3 = a2 + kstep; const char* b3 = b2 + kstep;
            PG8_LDB(B0, 0, 0); PG8_LDB(B1, 0, 1); PG8_SCHED; PG8_LDA(At, 0, 0); PG8_STAGE(PG8_SA(1, 1), a1 + hstep);
            PG8_WAIT_V(8); PG8_WAIT_L(0); PG8_BAR; PG8_MMA(0, 0, At, B0); PG8_MMA(0, 1, At, B1); PG8_BAR; PG8_SCHED;
            PG8_LDA(At, 0, 1); PG8_STAGE(PG8_SB(0, 0), b2); PG8_STAGE(PG8_SB(0, 1), b2 + hstep); PG8_STAGE(PG8_SA(0, 0), a2);
            PG8_WAIT_V(8); PG8_WAIT_L(0); PG8_BAR; PG8_MMA(1, 0, At, B0); PG8_MMA(1, 1, At, B1); PG8_BAR; PG8_SCHED;
            PG8_LDB(B0, 1, 0); PG8_LDB(B1, 1, 1); PG8_SCHED; PG8_LDA(At, 1, 0); PG8_STAGE(PG8_SA(0, 1), a2 + hstep);
            PG8_WAIT_V(8); PG8_WAIT_L(0); PG8_BAR; PG8_MMA(0, 0, At, B0); PG8_MMA(0, 1, At, B1); PG8_BAR; PG8_SCHED;
            PG8_LDA(At, 1, 1); PG8_STAGE(PG8_SB(1, 0), b3); PG8_STAGE(PG8_SB(1, 1), b3 + hstep); PG8_STAGE(PG8_SA(1, 0), a3);
            PG8_WAIT_V(8); PG8_WAIT_L(0); PG8_BAR; PG8_MMA(1, 0, At, B0); PG8_MMA(1, 1, At, B1); PG8_BAR; PG8_SCHED;
        }
        if (wr == 0) PG8_BAR;
        E(acc, cur, wr, wc, fr, fq);
        if (!has_next) break;
        if (!Epi::keep(cur))
#pragma unroll
        for (int a = 0; a < 2; ++a)
#pragma unroll
            for (int b = 0; b < 2; ++b)
#pragma unroll
                for (int m = 0; m < 4; ++m)
#pragma unroll
                    for (int n = 0; n < 2; ++n) acc[a][b][m][n] = (f32x4){0.f, 0.f, 0.f, 0.f};
        cur = nxt; cA = nA; cB = nB; ++ui;
        if (wr == 1) PG8_BAR;
    }
    PG8_WAIT_V(0);
    PG8_BAR;
#undef PG8_SA
#undef PG8_SB
#undef PG8_STAGE
#undef PG8_LDA
#undef PG8_LDB
#undef PG8_MMA
#undef PG8_WAIT_V
#undef PG8_WAIT_L
#undef PG8_BAR
#undef PG8_SCHED
}
}

typedef f32x4 AccT[2][2][4][2];

struct EpiQKV {
    static DI bool keep(const pg8::Unit&) { return false; }
    bf16_t* Q; float* AB; const float* biasp;
    DI void operator()(const AccT& acc, const pg8::Unit& u, int wr, int wc, int fr, int fq) const {
        const int row0 = u.pm * 256 + wr * 64 + fr;
        if (u.pn == 12) {
            if (wc == 0) {
                const f32x4 b0 = *(const f32x4*)(biasp + 12 * 256 + 4 * fq), b1 = *(const f32x4*)(biasp + 12 * 256 + 16 + 4 * fq);
#pragma unroll
                for (int ai = 0; ai < 2; ++ai)
#pragma unroll
                    for (int m = 0; m < 4; ++m) {
                        float* p = AB + (size_t)(row0 + ai * 128 + m * 16) * 32 + 8 * fq;
                        *(f32x4*)p = acc[ai][0][m][0] + b0; *(f32x4*)(p + 4) = acc[ai][0][m][1] + b1;
                    }
            }
        } else {
            bf16_t* base = Q + (size_t)(u.pn >> 2) * ((WS_K - WS_Q) / 2);
            const int colt = (u.pn & 3) * 256;
#pragma unroll
            for (int bj = 0; bj < 2; ++bj) {
                const int so = u.pn * 256 + bj * 128 + wc * 32 + 4 * fq;
                const f32x4 b0 = *(const f32x4*)(biasp + so), b1 = *(const f32x4*)(biasp + so + 16);
                const int col = colt + bj * 128 + wc * 32 + 8 * fq;
#pragma unroll
                for (int ai = 0; ai < 2; ++ai)
#pragma unroll
                    for (int m = 0; m < 4; ++m) {
                        const f32x4 v0 = acc[ai][bj][m][0] + b0, v1 = acc[ai][bj][m][1] + b1;
                        u32x4 w; w.x = pk2(v0[0], v0[1]); w.y = pk2(v0[2], v0[3]); w.z = pk2(v1[0], v1[1]); w.w = pk2(v1[2], v1[3]);
                        *(u32x4*)(base + (size_t)(row0 + ai * 128 + m * 16) * 1024 + col) = w;
                    }
            }
        }
    }
};

struct EpiRest {
    static DI bool keep(const pg8::Unit&) { return false; }
    bf16_t* ZA; bf16_t* YB; bf16_t* SA; bf16_t* SB; const float* biasp; const float* cw; const float* cb;
    DI void operator()(const AccT& acc, const pg8::Unit& u, int wr, int wc, int fr, int fq) const {
        const int row0 = u.pm * 256 + wr * 64 + fr;
        const int t = u.pn;
        if (t >= 4 && t < 20) {
            const int chl = 64 * (t - 4) + 16 * wc + 4 * fq;
            const int so = t * 256 + wc * 32 + 4 * fq;
            const f32x4 bxi = *(const f32x4*)(biasp + so), bcg = *(const f32x4*)(biasp + so + 16), bbg = *(const f32x4*)(biasp + so + 128), bzb = *(const f32x4*)(biasp + so + 144);
            const f32x4 w0 = *(const f32x4*)(cw + chl), w1 = *(const f32x4*)(cw + 1024 + chl), w2 = *(const f32x4*)(cw + 2048 + chl), cbv = *(const f32x4*)(cb + chl);
#pragma unroll
            for (int ai = 0; ai < 2; ++ai) {
                f32x4 xc[4], rp[4], rn[4];
#pragma unroll
                for (int m = 0; m < 4; ++m) {
                    xc[m] = (acc[ai][0][m][0] + bxi) * (acc[ai][0][m][1] + bcg);
#pragma unroll
                    for (int j = 0; j < 4; ++j) { rp[m][j] = dppf<0x121>(xc[m][j]); rn[m][j] = dppf<0x12F>(xc[m][j]); }
                }
#pragma unroll
                for (int m = 0; m < 4; ++m) {
                    f32x4 pv, nv;
#pragma unroll
                    for (int j = 0; j < 4; ++j) {
                        pv[j] = (fr == 0) ? (m > 0 ? rp[m > 0 ? m - 1 : 0][j] : 0.f) : rp[m][j];
                        nv[j] = (fr == 15) ? (m < 3 ? rn[m < 3 ? m + 1 : 3][j] : 0.f) : rn[m][j];
                    }
                    const f32x4 bg = acc[ai][1][m][0] + bbg, zb = acc[ai][1][m][1] + bzb;
                    float y[4];
#pragma unroll
                    for (int j = 0; j < 4; ++j) y[j] = bg[j] * siluf_(zb[j]) * (w0[j] * pv[j] + w1[j] * xc[m][j] + w2[j] * nv[j] + cbv[j]);
                    u32x2 w; w.x = pk2(y[0], y[1]); w.y = pk2(y[2], y[3]);
                    *(u32x2*)(YB + (size_t)(row0 + ai * 128 + m * 16) * 1024 + chl) = w;
                }
            }
            return;
        }
#pragma unroll
        for (int bj = 0; bj < 2; ++bj) {
            const int so = t * 256 + bj * 128 + wc * 32 + 4 * fq;
            const f32x4 b0 = *(const f32x4*)(biasp + so), b1 = *(const f32x4*)(biasp + so + 16);
            if (t < 4) {
                const int col = t * 256 + bj * 128 + wc * 32 + 8 * fq;
#pragma unroll
                for (int ai = 0; ai < 2; ++ai)
#pragma unroll
                    for (int m = 0; m < 4; ++m) {
                        f32x4 v0 = acc[ai][bj][m][0] + b0, v1 = acc[ai][bj][m][1] + b1;
#pragma unroll
                        for (int j = 0; j < 4; ++j) { v0[j] = siluf_(v0[j]); v1[j] = siluf_(v1[j]); }
                        u32x4 w; w.x = pk2(v0[0], v0[1]); w.y = pk2(v0[2], v0[3]); w.z = pk2(v1[0], v1[1]); w.w = pk2(v1[2], v1[3]);
                        *(u32x4*)(ZA + (size_t)(row0 + ai * 128 + m * 16) * 1024 + col) = w;
                    }
            } else if (bj == 0) {
                const int ch = (t - 20) * 128 + 32 * wc + 8 * fq;
                const int so1 = t * 256 + 128 + wc * 32 + 4 * fq;
                const f32x4 c0 = *(const f32x4*)(biasp + so1), c1 = *(const f32x4*)(biasp + so1 + 16);
#pragma unroll
                for (int ai = 0; ai < 2; ++ai)
#pragma unroll
                    for (int m = 0; m < 4; ++m) {
                        const f32x4 a0 = acc[ai][0][m][0] + b0, a1 = acc[ai][0][m][1] + b1, g0 = acc[ai][1][m][0] + c0, g1 = acc[ai][1][m][1] + c1;
                        const size_t o = (size_t)(row0 + ai * 128 + m * 16) * 1024 + ch;
                        float ea[8], ec[8];
#pragma unroll
                        for (int j = 0; j < 4; ++j) { ea[j] = 1.f + __expf(-a0[j]); ea[4 + j] = 1.f + __expf(-a1[j]); ec[j] = 1.f + __expf(-g0[j]); ec[4 + j] = 1.f + __expf(-g1[j]); }
                        u32x4 w, w2;
                        w.x = pk2(ec[0] * __builtin_amdgcn_rcpf(ea[0]), ec[1] * __builtin_amdgcn_rcpf(ea[1])); w.y = pk2(ec[2] * __builtin_amdgcn_rcpf(ea[2]), ec[3] * __builtin_amdgcn_rcpf(ea[3]));
                        w.z = pk2(ec[4] * __builtin_amdgcn_rcpf(ea[4]), ec[5] * __builtin_amdgcn_rcpf(ea[5])); w.w = pk2(ec[6] * __builtin_amdgcn_rcpf(ea[6]), ec[7] * __builtin_amdgcn_rcpf(ea[7]));
                        w2.x = pk2(__builtin_amdgcn_rcpf(ec[0]), __builtin_amdgcn_rcpf(ec[1])); w2.y = pk2(__builtin_amdgcn_rcpf(ec[2]), __builtin_amdgcn_rcpf(ec[3]));
                        w2.z = pk2(__builtin_amdgcn_rcpf(ec[4]), __builtin_amdgcn_rcpf(ec[5])); w2.w = pk2(__builtin_amdgcn_rcpf(ec[6]), __builtin_amdgcn_rcpf(ec[7]));
                        *(u32x4*)(SA + o) = w; *(u32x4*)(SB + o) = w2;
                    }
            }
        }
    }
};

struct EpiMergePair {
    static constexpr int DPM = 272, DPN = 4;
    bf16_t* MG; const bf16_t* SA; const bf16_t* SB;
    static DI bool keep(const pg8::Unit& u) { return u.pm < DPM; }
    DI void operator()(AccT& acc, const pg8::Unit& u, int wr, int wc, int fr, int fq) const {
        const bool first = u.pm < DPM;
        const int pm = first ? u.pm : u.pm - DPM, pn = first ? u.pn : u.pn - DPN;
        const int row0 = pm * 256 + wr * 64 + fr;
#pragma unroll
        for (int bj = 0; bj < 2; ++bj) {
            const int col = pn * 256 + bj * 128 + wc * 32 + 8 * fq;
#pragma unroll
            for (int ai = 0; ai < 2; ++ai)
#pragma unroll
                for (int m = 0; m < 4; ++m) {
                    const size_t o = (size_t)(row0 + ai * 128 + m * 16) * 1024 + col;
                    if (first) {
                        const u32x4 rv = *(const u32x4*)(SA + o);
                        const float rr[8] = {bflo(rv.x), bfhi(rv.x), bflo(rv.y), bfhi(rv.y), bflo(rv.z), bfhi(rv.z), bflo(rv.w), bfhi(rv.w)};
#pragma unroll
                        for (int j = 0; j < 4; ++j) { acc[ai][bj][m][0][j] *= rr[j]; acc[ai][bj][m][1][j] *= rr[4 + j]; }
                    } else {
                        const u32x4 bv = *(const u32x4*)(SB + o);
                        const float sb[8] = {bflo(bv.x), bfhi(bv.x), bflo(bv.y), bfhi(bv.y), bflo(bv.z), bfhi(bv.z), bflo(bv.w), bfhi(bv.w)};
                        const f32x4 v0 = acc[ai][bj][m][0], v1 = acc[ai][bj][m][1];
                        u32x4 w; w.x = pk2(v0[0] * sb[0], v0[1] * sb[1]); w.y = pk2(v0[2] * sb[2], v0[3] * sb[3]); w.z = pk2(v1[0] * sb[4], v1[1] * sb[5]); w.w = pk2(v1[2] * sb[6], v1[3] * sb[7]);
                        *(u32x4*)(MG + o) = w;
                    }
                }
        }
    }
};

struct EpiOut {
    static DI bool keep(const pg8::Unit&) { return false; }
    bf16_t* Y;
    DI void operator()(const AccT& acc, const pg8::Unit& u, int wr, int wc, int fr, int fq) const {
        const int row0 = u.pm * 256 + wr * 64 + fr;
#pragma unroll
        for (int bj = 0; bj < 2; ++bj) {
            const int col = u.pn * 256 + bj * 128 + wc * 32 + 8 * fq;
#pragma unroll
            for (int ai = 0; ai < 2; ++ai)
#pragma unroll
                for (int m = 0; m < 4; ++m) {
                    const f32x4 v0 = acc[ai][bj][m][0], v1 = acc[ai][bj][m][1];
                    u32x4 w; w.x = pk2(v0[0], v0[1]); w.y = pk2(v0[2], v0[3]); w.z = pk2(v1[0], v1[1]); w.w = pk2(v1[2], v1[3]);
                    *(u32x4*)(Y + (size_t)(row0 + ai * 128 + m * 16) * 1024 + col) = w;
                }
        }
    }
};

DI void prep_weight(LAS unsigned char* lds, const float* src, int ld, bf16_t* dst, int nslot, int mode, int& job, int G) {
    LAS float* tile = (LAS float*)lds;
    const int tid = threadIdx.x;
    const int ntile = (nslot / 64) * 16;
    const int sl_r = tid & 63, kl0 = tid >> 6;
    float v[8];
    auto ldtile = [&](int jb) {
        const int s0 = (jb >> 4) * 64, k0 = (jb & 15) * 64;
        const int sc = mode ? plaincol(s0 + sl_r) : srccol(s0 + sl_r);
#pragma unroll
        for (int e = 0; e < 8; ++e) v[e] = (sc >= 0) ? src[(size_t)(k0 + kl0 + 8 * e) * ld + sc] : 0.f;
    };
    if (job < ntile) ldtile(job);
    for (; job < ntile; job += G) {
        const int s0 = (job >> 4) * 64, k0 = (job & 15) * 64;
#pragma unroll
        for (int e = 0; e < 8; ++e) tile[(kl0 + 8 * e) * 65 + sl_r] = v[e];
        if (job + G < ntile) ldtile(job + G);
        lbar();
        {
            const int sl = tid >> 3, kq = tid & 7;
            float w8[8];
#pragma unroll
            for (int e = 0; e < 8; ++e) w8[e] = tile[(kq * 8 + e) * 65 + sl];
            u32x4 w; w.x = pk2(w8[0], w8[1]); w.y = pk2(w8[2], w8[3]); w.z = pk2(w8[4], w8[5]); w.w = pk2(w8[6], w8[7]);
            *(u32x4*)(dst + (size_t)(s0 + sl) * 1024 + k0 + kq * 8) = w;
        }
        lbar();
    }
    job -= ntile;
}

DI void phase0(const Params& p, LAS unsigned char* lds) {
    const int tid = threadIdx.x, G = gridDim.x;
    unsigned char* ws = p.ws;
    {
        LAS float* sc = (LAS float*)lds;
        LAS float* part = (LAS float*)(lds + 9 * 1024 * 4);
        const float* c = p.in[1]; const float* cctx = p.in[3]; const float* wmod = p.in[4]; const float* bmod = p.in[5];
        float* MOD = (float*)(ws + WS_MOD);
        for (int i = tid; i < 9 * 1024; i += NTHR) { const float v = (i < 8192) ? c[i] : cctx[i - 8192]; sc[i] = siluf_(v); }
        __syncthreads();
        for (int blk = blockIdx.x; blk < 256; blk += G) {
            if (tid < 504) {
                const int cl = tid % 12, kg = tid / 12;
                float a[9];
#pragma unroll
                for (int v = 0; v < 9; ++v) a[v] = 0.f;
#pragma unroll 5
                for (int k = kg; k < 1024; k += 42) {
                    const float w = wmod[(size_t)k * 3072 + blk * 12 + cl];
#pragma unroll
                    for (int v = 0; v < 9; ++v) a[v] += sc[v * 1024 + k] * w;
                }
#pragma unroll
                for (int v = 0; v < 9; ++v) part[(kg * 9 + v) * 12 + cl] = a[v];
            }
            __syncthreads();
            if (tid < 108) {
                const int v = tid / 12, cl = tid % 12;
                float s = 0.f;
                for (int kg = 0; kg < 42; ++kg) s += part[(kg * 9 + v) * 12 + cl];
                MOD[v * 3072 + blk * 12 + cl] = s + bmod[blk * 12 + cl];
            }
            __syncthreads();
        }
    }
    {
        float* BP = (float*)(ws + WS_BIASP); const float* bin = p.in[7];
        for (int s = blockIdx.x * NTHR + tid; s < NSLOT; s += G * NTHR) { const int sc = srccol(s); BP[s] = sc >= 0 ? bin[sc] : 0.f; }
    }
    int job = blockIdx.x;
    prep_weight(lds, p.in[6], INCOLS, (bf16_t*)(ws + WS_WINT), NSLOT, 0, job, G);
    prep_weight(lds, p.in[14], 1024, (bf16_t*)(ws + WS_WAT), 1024, 1, job, G);
    prep_weight(lds, p.in[15], 1024, (bf16_t*)(ws + WS_WBT), 1024, 1, job, G);
    prep_weight(lds, p.in[16], 1024, (bf16_t*)(ws + WS_WOT), 1024, 1, job, G);
}

DI void phase_ln_mod(const Params& p) {
    const int lane = threadIdx.x & 63, wid = threadIdx.x >> 6;
    const float* MOD = (const float*)(p.ws + WS_MOD);
    bf16_t* HX = (bf16_t*)(p.ws + WS_QKHX);
    const int stride = gridDim.x * 8;
    int row = blockIdx.x * 8 + wid;
    f32x4 xv[4], nx[4];
    auto rowsrc = [&](int r) { return (r < XR) ? p.in[0] + (size_t)r * 1024 : p.in[2] + (size_t)(r - XR) * 1024; };
    if (row < ROWS) {
        const float* src = rowsrc(row);
#pragma unroll
        for (int i = 0; i < 4; ++i) xv[i] = *(const f32x4*)(src + i * 256 + lane * 4);
    }
    for (; row < ROWS; row += stride) {
        const int v = (row < XR) ? (row >> 12) : 8;
        f32x4 shv[4], sclv[4];
#pragma unroll
        for (int i = 0; i < 4; ++i) { shv[i] = *(const f32x4*)(MOD + v * 3072 + i * 256 + lane * 4); sclv[i] = *(const f32x4*)(MOD + v * 3072 + 1024 + i * 256 + lane * 4); }
        if (row + stride < ROWS) {
            const float* src = rowsrc(row + stride);
#pragma unroll
            for (int i = 0; i < 4; ++i) nx[i] = *(const f32x4*)(src + i * 256 + lane * 4);
        }
        float s = 0.f;
#pragma unroll
        for (int i = 0; i < 4; ++i) s += xv[i][0] + xv[i][1] + xv[i][2] + xv[i][3];
#pragma unroll
        for (int o = 1; o < 64; o <<= 1) s += __shfl_xor(s, o);
        const float mu = s * (1.f / 1024.f);
        float q = 0.f;
#pragma unroll
        for (int i = 0; i < 4; ++i)
#pragma unroll
            for (int j = 0; j < 4; ++j) { const float d = xv[i][j] - mu; q += d * d; }
#pragma unroll
        for (int o = 1; o < 64; o <<= 1) q += __shfl_xor(q, o);
        const float rstd = rsqrtf(q * (1.f / 1024.f) + 1e-5f);
#pragma unroll
        for (int i = 0; i < 4; ++i) {
            const int col = i * 256 + lane * 4;
            const f32x4 sh = shv[i], scl = sclv[i];
            float y[4];
#pragma unroll
            for (int j = 0; j < 4; ++j) y[j] = (xv[i][j] - mu) * rstd * (1.f + scl[j]) + sh[j];
            u32x2 w; w.x = pk2(y[0], y[1]); w.y = pk2(y[2], y[3]);
            *(u32x2*)(HX + (size_t)row * 1024 + col) = w;
        }
#pragma unroll
        for (int i = 0; i < 4; ++i) xv[i] = nx[i];
    }
}

constexpr int P3_QS = 0, P3_KS = 17408, P3_VT = 34816, P3_KT = 53248, P3_M = 71680, P3_TB = 104448, P3_GC = 141312, P3_BETA = 141824;
#define MFMA32(a, b, c) __builtin_amdgcn_mfma_f32_32x32x16_bf16((a), (b), (c), 0, 0, 0)

DI void phase_gdn_pre(const Params& p, LAS unsigned char* lds, const bool dry) {
    const int tid = threadIdx.x, lane = tid & 63, wid = __builtin_amdgcn_readfirstlane(tid >> 6), r = lane & 31, hh = lane >> 5;
    unsigned char* ws = p.ws;
    bf16_t* Qb = (bf16_t*)(ws + WS_Q); bf16_t* Kb = (bf16_t*)(ws + WS_K); bf16_t* Vb = (bf16_t*)(ws + WS_V);
    bf16_t* QC = (bf16_t*)(ws + WS_QC); bf16_t* KC = (bf16_t*)(ws + WS_KC);
    const float* AB = (const float*)(ws + WS_AB); float* GCg = (float*)(ws + WS_GC);
    bf16_t* Ug = (bf16_t*)(ws + WS_U);
    bf16_t* WX = (bf16_t*)p.out; bf16_t* WCTX = (bf16_t*)(ws + WS_WCTX);
    const float* convw = p.in[8]; const float* alog = p.in[9]; const float* dtbias = p.in[10];
    LAS float* const gcs_all = (LAS float*)(lds + P3_GC2); LAS float* const betas_all = (LAS float*)(lds + P3_BETA2);
    LAS float* Ms = (LAS float*)(lds + P3_M);

    unsigned raw[3][6][2]; float abv[2] = {0.f, 0.f};
    auto load_raw = [&](int it) {
        const bool isx = it < 4096;
        int b, h, n;
        if (isx) { b = it >> 9; h = (it >> 6) & 7; n = it & 63; } else { const int ci = it - 4096; b = ci >> 5; h = (ci >> 2) & 7; n = ci & 3; }
        const size_t rowbase = isx ? (size_t)b * 4096 + n * 64 : (size_t)XR + b * 256 + n * 64;
        const int seqpos0 = isx ? 0 : n * 64, seqlen = isx ? 64 : 256;
        const int tg = tid >> 5, cq = tid & 31;
#pragma unroll
        for (int sec = 0; sec < 3; ++sec) {
            const bf16_t* src = (sec == 0 ? Qb : (sec == 1 ? Kb : Vb)) + rowbase * 1024 + h * 128 + 4 * cq;
#pragma unroll
            for (int rr = 0; rr < 6; ++rr) {
                const int lt = 4 * tg - 1 + rr, pos = seqpos0 + lt;
                u32x2 v = {0u, 0u};
                if (pos >= 0 && pos < seqlen) v = *(const u32x2*)(src + (long)lt * 1024);
                raw[sec][rr][0] = v.x; raw[sec][rr][1] = v.y;
            }
        }
        if (wid == 4 || wid == 5) {
            const int d = wid - 4, lt = d ? 63 - lane : lane;
            abv[0] = AB[(rowbase + lt) * 32 + d * 8 + h]; abv[1] = AB[(rowbase + lt) * 32 + 16 + d * 8 + h];
        }
    };
    auto bstage = [&](int it2, int buf) {
        const bool isx2 = it2 < 4096;
        int b2, h2, n2;
        if (isx2) { b2 = it2 >> 9; h2 = (it2 >> 6) & 7; n2 = it2 & 63; } else { const int ci = it2 - 4096; b2 = ci >> 5; h2 = (ci >> 2) & 7; n2 = ci & 3; }
        const int gchunk2 = isx2 ? 4 + n2 : n2;
        const int d = wid - 4, cp = lane;
        const float a = abv[0], bl = abv[1];
        const float arate = __expf(alog[d * 8 + h2]), dtb = dtbias[d * 8 + h2];
        const float xx = a + dtb;
        const float ee = __expf(-fabsf(xx));
        const float l1p = (ee < 0.03125f) ? ee * (1.f + ee * (-0.5f + ee * (0.33333333f - 0.25f * ee))) : __logf(1.f + ee);
        const float sp = fmaxf(xx, 0.f) + l1p;
        float g = -arate * sp;
#pragma unroll
        for (int o = 1; o < 64; o <<= 1) { const float t = __shfl_up(g, o); if (lane >= o) g += t; }
        gcs_all[buf * 128 + d * 64 + cp] = g; betas_all[buf * 128 + d * 64 + cp] = sigmoidf_(bl);
        GCg[((size_t)((b2 * 8 + h2) * 2 + d) * NCHUNK + gchunk2) * 64 + cp] = g;
    };
    const int hA = (blockIdx.x >> 6) & 7, hB = (hA + 4) & 7;
    LAS float* CW = (LAS float*)(lds + P3_CW);
    for (int i = tid; i < 2304; i += NTHR) {
        const int hs = i / 1152, rem = i % 1152, tap = rem / 384, c = rem % 384;
        CW[i] = convw[tap * 3072 + (c >> 7) * 1024 + (hs ? hB : hA) * 128 + (c & 127)];
    }
    if (blockIdx.x < 4352) { load_raw(blockIdx.x); if (wid == 4 || wid == 5) bstage(blockIdx.x, 0); }
    lbar();
    int kit = 0;
    for (int it = blockIdx.x; it < 4352; it += gridDim.x, ++kit) {
        LAS float* gcs = gcs_all + (kit & 1) * 128; LAS float* betas = betas_all + (kit & 1) * 128;
        const bool isx = it < 4096;
        int b, h, n;
        if (isx) { b = it >> 9; h = (it >> 6) & 7; n = it & 63; } else { const int ci = it - 4096; b = ci >> 5; h = (ci >> 2) & 7; n = ci & 3; }
        const int gchunk = isx ? 4 + n : n;
        const size_t rowbase = isx ? (size_t)b * 4096 + n * 64 : (size_t)XR + b * 256 + n * 64;
        const int tg = tid >> 5, cq = tid & 31;
        unsigned pk[3][4][2];
#pragma unroll
        for (int sec = 0; sec < 3; ++sec) {
            float in[6][4];
#pragma unroll
            for (int rr = 0; rr < 6; ++rr) { in[rr][0] = bflo(raw[sec][rr][0]); in[rr][1] = bfhi(raw[sec][rr][0]); in[rr][2] = bflo(raw[sec][rr][1]); in[rr][3] = bfhi(raw[sec][rr][1]); }
            f32x4 w0, w1, w2;
            if (h == hA || h == hB) {
                const LAS float* cwp = CW + (h == hA ? 0 : 1152) + sec * 128 + 4 * cq;
                w0 = *(const LAS f32x4*)cwp; w1 = *(const LAS f32x4*)(cwp + 384); w2 = *(const LAS f32x4*)(cwp + 768);
            } else {
                w0 = *(const f32x4*)(convw + 0 * 3072 + sec * 1024 + h * 128 + 4 * cq);
                w1 = *(const f32x4*)(convw + 1 * 3072 + sec * 1024 + h * 128 + 4 * cq);
                w2 = *(const f32x4*)(convw + 2 * 3072 + sec * 1024 + h * 128 + 4 * cq);
            }
#pragma unroll
            for (int t = 0; t < 4; ++t) {
                float o4[4];
#pragma unroll
                for (int j = 0; j < 4; ++j) o4[j] = siluf_(w0[j] * in[t][j] + w1[j] * in[t + 1][j] + w2[j] * in[t + 2][j]);
                if (sec < 2) {
                    const float ss = sum32(o4[0] * o4[0] + o4[1] * o4[1] + o4[2] * o4[2] + o4[3] * o4[3]);
                    const float rs = rsqrtf(ss + 1e-6f) * (sec == 0 ? 0.08838834764831845f : 1.f);
#pragma unroll
                    for (int j = 0; j < 4; ++j) o4[j] *= rs;
                }
                pk[sec][t][0] = pk2(o4[0], o4[1]); pk[sec][t][1] = pk2(o4[2], o4[3]);
            }
        }
        lbar();
        {
            bf16_t* qd = isx ? Qb + rowbase * 1024 : QC + ((size_t)b * 256 + n * 64) * 1024;
            bf16_t* kd = isx ? Kb + rowbase * 1024 : KC + ((size_t)b * 256 + n * 64) * 1024;
#pragma unroll
            for (int t = 0; t < 4; ++t) {
                const int lt = 4 * tg + t;
                u32x2 wq = {pk[0][t][0], pk[0][t][1]}, wk = {pk[1][t][0], pk[1][t][1]};
                if (!dry) {
                    *(u32x2*)(qd + (size_t)lt * 1024 + h * 128 + 4 * cq) = wq;
                    *(u32x2*)(kd + (size_t)lt * 1024 + h * 128 + 4 * cq) = wk;
                }
                *(LAS u32x2*)(lds + P3_QS + lt * 272 + 8 * cq) = wq;
                *(LAS u32x2*)(lds + P3_KS + lt * 272 + 8 * cq) = wk;
            }
#pragma unroll
            for (int j = 0; j < 4; ++j) {
                const int sh = (j & 1) * 16, wi = j >> 1;
                u32x2 tk, tv;
                tk.x = ((pk[1][0][wi] >> sh) & 0xffffu) | (((pk[1][1][wi] >> sh) & 0xffffu) << 16);
                tk.y = ((pk[1][2][wi] >> sh) & 0xffffu) | (((pk[1][3][wi] >> sh) & 0xffffu) << 16);
                tv.x = ((pk[2][0][wi] >> sh) & 0xffffu) | (((pk[2][1][wi] >> sh) & 0xffffu) << 16);
                tv.y = ((pk[2][2][wi] >> sh) & 0xffffu) | (((pk[2][3][wi] >> sh) & 0xffffu) << 16);
                *(LAS u32x2*)(lds + P3_KT + (4 * cq + j) * 144 + 8 * tg) = tk;
                *(LAS u32x2*)(lds + P3_VT + (4 * cq + j) * 144 + 8 * tg) = tv;
            }
        }
        lbar();
        if (it + (int)gridDim.x < 4352) load_raw(it + gridDim.x);
        {
            const int sel = wid >> 2, mt = (wid >> 1) & 1, nt = wid & 1;
            const LAS unsigned char* Ab = lds + (sel ? P3_QS : P3_KS) + (32 * mt + r) * 272 + 16 * hh;
            const LAS unsigned char* Bb = lds + P3_KS + (32 * nt + r) * 272 + 16 * hh;
            f32x16 acc;
#pragma unroll
            for (int i = 0; i < 16; ++i) acc[i] = 0.f;
#pragma unroll
            for (int ks = 0; ks < 8; ++ks) acc = MFMA32(*(const LAS bf16x8*)(Ab + 32 * ks), *(const LAS bf16x8*)(Bb + 32 * ks), acc);
            const int s = 32 * nt + r, cb = 32 * mt + 4 * hh;
#pragma unroll
            for (int d = 0; d < 2; ++d) {
                const int sp = d ? 63 - s : s, cpb = d ? 63 - cb : cb;
                const float gs = gcs[d * 64 + sp];
                const LAS float* gb = gcs + d * 64 + cpb; const LAS float* bb = betas + d * 64 + cpb;
                LAS float* mb = Ms + d * 4096 + cpb * 64 + sp;
                bf16_t* qb = Vb + (rowbase + cpb) * 1024 + h * 128 + d * 64 + sp;
                float vq[16];
#pragma unroll
                for (int i = 0; i < 16; ++i) {
                    const int dc = d ? -((i & 3) + 8 * (i >> 2)) : ((i & 3) + 8 * (i >> 2));
                    const int cp = cpb + dc;
                    const float e = __expf(gb[dc] - gs);
                    if (sel == 0) mb[dc * 64] = (sp < cp) ? bb[dc] * acc[i] * e : 0.f;
                    else vq[i] = (sp <= cp) ? acc[i] * e : 0.f;
                }
                if (sel == 1 && isx && !dry) {
                    const bool lowlane = (sp & 1) == 0;
                    bf16_t* qb2 = Vb + (rowbase + cpb) * 1024 + h * 128 + d * 64 + (sp & ~1);
#pragma unroll
                    for (int i = 0; i < 16; i += 2) {
                        const int dc0 = d ? -((i & 3) + 8 * (i >> 2)) : ((i & 3) + 8 * (i >> 2));
                        const int dc1 = d ? -(((i + 1) & 3) + 8 * ((i + 1) >> 2)) : (((i + 1) & 3) + 8 * ((i + 1) >> 2));
                        const float recv = dppf<0xB1>(lowlane ? vq[i + 1] : vq[i]);
                        const unsigned w = lowlane ? pk2(vq[i], recv) : pk2(recv, vq[i + 1]);
                        *(unsigned*)(qb2 + (lowlane ? dc0 : dc1) * 1024) = w;
                    }
                }
            }
        }
        lbar();
        if (wid < 2) {
            const int d = wid; int ln = lane; asm volatile("" : "+v"(ln));
            const int half = ln >> 5, jj = ln & 31;
            LAS float* Mr = Ms + d * 4096;
            const LAS float* Mb = Mr + (32 * half) * 64 + 32 * half;
            float t[32];
            t[0] = (jj == 0) ? 1.f : 0.f;
#pragma unroll
            for (int i = 1; i < 32; ++i) {
                f32x4 cur[8];
#pragma unroll
                for (int l4 = 0; l4 < (i + 3) / 4; ++l4) cur[l4] = *(const LAS f32x4*)(Mb + i * 64 + 4 * l4);
                __builtin_amdgcn_sched_barrier(0);
                float a0 = (i == jj) ? 1.f : 0.f, a1 = 0.f, a2 = 0.f, a3 = 0.f;
#pragma unroll
                for (int l4 = 0; l4 < (i + 3) / 4; ++l4) {
                    if (4 * l4 + 0 < i) a0 -= cur[l4][0] * t[4 * l4 + 0];
                    if (4 * l4 + 1 < i) a1 -= cur[l4][1] * t[4 * l4 + 1];
                    if (4 * l4 + 2 < i) a2 -= cur[l4][2] * t[4 * l4 + 2];
                    if (4 * l4 + 3 < i) a3 -= cur[l4][3] * t[4 * l4 + 3];
                }
                t[i] = (a0 + a1) + (a2 + a3);
                __builtin_amdgcn_sched_barrier(0);
            }
            if (half == 0) {
#pragma unroll
                for (int q = 0; q < 8; ++q) *(LAS f32x4*)(Mr + jj * 64 + 32 + 4 * q) = (f32x4){t[4 * q], t[4 * q + 1], t[4 * q + 2], t[4 * q + 3]};
            } else {
#pragma unroll
                for (int i = 0; i < 32; ++i) Mr[i * 64 + jj] = t[i];
            }
            f32x4 av[4], bv[4];
#pragma unroll
            for (int q = 0; q < 4; ++q) { av[q] = *(const LAS f32x4*)(Mr + (32 + jj) * 64 + 16 * half + 4 * q); bv[q] = *(const LAS f32x4*)(Mr + jj * 64 + 32 + 16 * half + 4 * q); }
            f32x16 P, R;
#pragma unroll
            for (int i = 0; i < 16; ++i) { P[i] = 0.f; R[i] = 0.f; }
#pragma unroll
            for (int ks = 0; ks < 16; ++ks) P = __builtin_amdgcn_mfma_f32_32x32x2f32(av[ks >> 2][ks & 3], bv[ks >> 2][ks & 3], P, 0, 0, 0);
            f32x4 a2v[4];
#pragma unroll
            for (int q = 0; q < 4; ++q) a2v[q] = *(const LAS f32x4*)(Mr + jj * 64 + 8 * q + 4 * half);
#pragma unroll
            for (int ks = 0; ks < 16; ++ks) R = __builtin_amdgcn_mfma_f32_32x32x2f32(a2v[ks >> 2][ks & 3], P[ks], R, 0, 0, 0);
            {
                const int spA = 32 * half + jj, spB = jj;
                const float bA = betas[d * 64 + spA], eA = bA * __expf(gcs[d * 64 + spA]);
                const float bB = betas[d * 64 + spB], eB = bB * __expf(gcs[d * 64 + spB]);
                const int colA = d ? 63 - spA : spA, colB = d ? 63 - spB : spB;
                LAS bf16_t* tb = (LAS bf16_t*)(lds + P3_TB + (d * 2 + 0) * 9216);
                LAS bf16_t* tg2 = (LAS bf16_t*)(lds + P3_TB + (d * 2 + 1) * 9216);
#pragma unroll
                for (int i = 0; i < 32; ++i) {
                    tb[(32 * half + i) * 72 + colA] = f2bf(t[i] * bA); tg2[(32 * half + i) * 72 + colA] = f2bf(-t[i] * eA);
                }
                if (half == 1) {
#pragma unroll
                    for (int i = 0; i < 32; ++i) { tb[i * 72 + colA] = 0; tg2[i * 72 + colA] = 0; }
                }
#pragma unroll
                for (int i = 0; i < 16; ++i) {
                    const int rr = 32 + crow(i, half);
                    tb[rr * 72 + colB] = f2bf(-R[i] * bB); tg2[rr * 72 + colB] = f2bf(R[i] * eB);
                }
            }
        }
        if ((wid == 4 || wid == 5) && it + (int)gridDim.x < 4352) bstage(it + gridDim.x, (kit + 1) & 1);
        lbar();
        {
            const int d = wid & 1, kind = (wid >> 1) & 1, tq = wid >> 2;
            const size_t idx = (size_t)((b * 8 + h) * 2 + d) * NCHUNK + gchunk;
            const LAS unsigned char* T = lds + P3_TB + (d * 2 + kind) * 9216;
#pragma unroll
            for (int q = 0; q < 4; ++q) {
                const int tl = tq * 4 + q;
                f32x16 acc;
#pragma unroll
                for (int i = 0; i < 16; ++i) acc[i] = 0.f;
                if (kind == 0) {
                    const int mt = tl & 1, nt = tl >> 1;
                    const LAS unsigned char* Ab = T + (32 * mt + r) * 144 + 16 * hh;
                    const LAS unsigned char* Bb = lds + P3_VT + (32 * nt + r) * 144 + 16 * hh;
#pragma unroll
                    for (int ks = 0; ks < 4; ++ks) acc = MFMA32(*(const LAS bf16x8*)(Ab + 32 * ks), *(const LAS bf16x8*)(Bb + 32 * ks), acc);
                    u32x4 w0, w1;
                    w0.x = pk2(acc[0], acc[1]); w0.y = pk2(acc[2], acc[3]); w0.z = pk2(acc[4], acc[5]); w0.w = pk2(acc[6], acc[7]);
                    w1.x = pk2(acc[8], acc[9]); w1.y = pk2(acc[10], acc[11]); w1.z = pk2(acc[12], acc[13]); w1.w = pk2(acc[14], acc[15]);
                    bf16_t* dst = Ug + idx * 8192 + ((nt * 2 + mt) * 64 + lane) * 16;
                    *(u32x4*)dst = w0; *(u32x4*)(dst + 8) = w1;
                } else {
                    const int mt = tl & 3, nt = tl >> 2;
                    const LAS unsigned char* Ab = lds + P3_KT + (32 * mt + r) * 144 + 16 * hh;
                    const LAS unsigned char* Bb = T + (32 * nt + r) * 144 + 16 * hh;
#pragma unroll
                    for (int ks = 0; ks < 4; ++ks) acc = MFMA32(*(const LAS bf16x8*)(Ab + 32 * ks), *(const LAS bf16x8*)(Bb + 32 * ks), acc);
                    bf16_t* wblk = isx ? WX + ((size_t)((b * 8 + h) * 2 + d) * 64 + n) * 8192 : WCTX + ((size_t)((b * 8 + h) * 2 + d) * 4 + n) * 8192;
                    bf16_t* dst = wblk + (32 * nt + r) * 128 + 32 * mt + 4 * hh;
#pragma unroll
                    for (int g4 = 0; g4 < 4; ++g4) {
                        u32x2 w; w.x = pk2(acc[4 * g4], acc[4 * g4 + 1]); w.y = pk2(acc[4 * g4 + 2], acc[4 * g4 + 3]);
                        *(u32x2*)(dst + 8 * g4) = w;
                    }
                }
            }
        }
        lbar();
    }
}

constexpr int P4_QD = 0, P4_W = 16896, P4_KDT = 33792, P4_QK = 51200, P4_DEC = 59904, P4_BUF = 59920;

DI bf16x8 ldsA(const LAS unsigned char* p) {
    const s16x4 lo = *(const LAS s16x4*)p, hi = *(const LAS s16x4*)(p + 16);
    return __builtin_shufflevector(lo, hi, 0, 1, 2, 3, 4, 5, 6, 7);
}
DI bf16x8 packf(const f32x16& x, int s) {
    u32x4 w; w.x = pk2(x[8 * s], x[8 * s + 1]); w.y = pk2(x[8 * s + 2], x[8 * s + 3]); w.z = pk2(x[8 * s + 4], x[8 * s + 5]); w.w = pk2(x[8 * s + 6], x[8 * s + 7]);
    return __builtin_bit_cast(bf16x8, w);
}

DI void phase_gdn_scan(const Params& p, LAS unsigned char* lds, const bool dry) {
    if (blockIdx.x >= 256) return;
    const int tid = threadIdx.x, lane = tid & 63, wid = __builtin_amdgcn_readfirstlane(tid >> 6), r = lane & 31, hh = lane >> 5;
    unsigned char* ws = p.ws;
    const int chain = blockIdx.x & 127, dvh = blockIdx.x >> 7, b = chain >> 4, h = (chain >> 1) & 7, d = chain & 1;
    const bf16_t* Qb = (const bf16_t*)(ws + WS_Q); const bf16_t* Kb = (const bf16_t*)(ws + WS_K);
    const bf16_t* QC = (const bf16_t*)(ws + WS_QC); const bf16_t* KC = (const bf16_t*)(ws + WS_KC);
    const float* GCg = (const float*)(ws + WS_GC);
    bf16_t* Ug = (bf16_t*)(ws + WS_U); const bf16_t* Vb = (const bf16_t*)(ws + WS_V);
    const bf16_t* WX = (const bf16_t*)p.out; const bf16_t* WCTX = (const bf16_t*)(ws + WS_WCTX);
    const size_t cbase = (size_t)((b * 8 + h) * 2 + d);
    auto gchunk_of = [&](int j) { return d ? (j < 4 ? 3 - j : 71 - j) : j; };

    u32x4 qv[4], kv[4], wv[4], qkv[2]; float gcv = 0.f, gl = 0.f;
    const int ptid = tid - 256, pcp = ptid >> 2, part = ptid & 3, plt = d ? 63 - pcp : pcp;
    auto issue = [&](int j) {
        const int g = gchunk_of(j);
        const size_t idx = cbase * NCHUNK + g;
        const size_t rowoff = (g < 4) ? ((size_t)b * 256 + g * 64 + plt) * 1024 : ((size_t)b * 4096 + (g - 4) * 64 + plt) * 1024;
        const bf16_t* qs = ((g < 4) ? QC : Qb) + rowoff + h * 128 + part * 32;
        const bf16_t* ks = ((g < 4) ? KC : Kb) + rowoff + h * 128 + part * 32;
        const bf16_t* wsrc = ((g < 4) ? WCTX + (cbase * 4 + g) * 8192 : WX + (cbase * 64 + (g - 4)) * 8192) + pcp * 128 + part * 32;
        const bf16_t* qks = Vb + ((g < 4) ? ((size_t)XR + b * 256 + g * 64 + pcp) : ((size_t)b * 4096 + (g - 4) * 64 + pcp)) * 1024 + h * 128 + d * 64 + part * 16;
#pragma unroll
        for (int i = 0; i < 4; ++i) { qv[i] = *(const u32x4*)(qs + 8 * i); kv[i] = *(const u32x4*)(ks + 8 * i); wv[i] = *(const u32x4*)(wsrc + 8 * i); }
        qkv[0] = *(const u32x4*)qks; qkv[1] = *(const u32x4*)(qks + 8);
        gcv = GCg[idx * 64 + pcp]; gl = GCg[idx * 64 + 63];
    };
    auto commit = [&](int j) {
        const float eq = __expf(gcv), ek = __expf(gl - gcv);
        LAS unsigned char* buf = lds + (j & 1) * P4_BUF;
        if (ptid == 0) *(LAS float*)(buf + P4_DEC) = __expf(gl);
        LAS unsigned char* qd = buf + P4_QD + pcp * 264 + part * 64;
        LAS unsigned char* wd = buf + P4_W + pcp * 264 + part * 64;
#pragma unroll
        for (int i = 0; i < 4; ++i) {
            u32x2 a, c2;
            a.x = pk2(bflo(qv[i].x) * eq, bfhi(qv[i].x) * eq); a.y = pk2(bflo(qv[i].y) * eq, bfhi(qv[i].y) * eq);
            c2.x = pk2(bflo(qv[i].z) * eq, bfhi(qv[i].z) * eq); c2.y = pk2(bflo(qv[i].w) * eq, bfhi(qv[i].w) * eq);
            *(LAS u32x2*)(qd + 16 * i) = a; *(LAS u32x2*)(qd + 16 * i + 8) = c2;
            u32x2 w0 = {wv[i].x, wv[i].y}, w1 = {wv[i].z, wv[i].w};
            *(LAS u32x2*)(wd + 16 * i) = w0; *(LAS u32x2*)(wd + 16 * i + 8) = w1;
        }
        LAS unsigned char* qkd = buf + P4_QK + pcp * 136 + part * 32;
#pragma unroll
        for (int i = 0; i < 2; ++i) {
            u32x2 w0 = {qkv[i].x, qkv[i].y}, w1 = {qkv[i].z, qkv[i].w};
            *(LAS u32x2*)(qkd + 16 * i) = w0; *(LAS u32x2*)(qkd + 16 * i + 8) = w1;
        }
        LAS bf16_t* kdt = (LAS bf16_t*)(buf + P4_KDT) + (part * 32) * 68 + pcp;
#pragma unroll
        for (int i = 0; i < 4; ++i) {
            const unsigned uu[4] = {kv[i].x, kv[i].y, kv[i].z, kv[i].w};
#pragma unroll
            for (int e = 0; e < 4; ++e) {
                const unsigned pk = pk2(bflo(uu[e]) * ek, bfhi(uu[e]) * ek);
                kdt[(8 * i + 2 * e) * 68] = (bf16_t)(pk & 0xffffu);
                kdt[(8 * i + 2 * e + 1) * 68] = (bf16_t)(pk >> 16);
            }
        }
    };

    f32x16 S[4];
#pragma unroll
    for (int m = 0; m < 4; ++m)
#pragma unroll
        for (int i = 0; i < 16; ++i) S[m][i] = 0.f;
    u32x4 un[4];
    auto loadu = [&](int j, u32x4 (&dst)[4]) {
        const bf16_t* up = Ug + (cbase * NCHUNK + gchunk_of(j)) * 8192 + (size_t)(((2 * dvh + wid) * 2) * 64 + lane) * 16;
        dst[0] = *(const u32x4*)up; dst[1] = *(const u32x4*)(up + 8); dst[2] = *(const u32x4*)(up + 1024); dst[3] = *(const u32x4*)(up + 1024 + 8);
    };
    if (wid >= 4) {
        issue(0); commit(0); issue(1);
        lbar();
        for (int j = 0; j < NCHUNK; ++j) {
            if (j + 1 < NCHUNK) commit(j + 1);
            if (j + 2 < NCHUNK) issue(j + 2);
            lbar();
        }
        return;
    }
    if (wid >= 2) { lbar(); for (int j = 0; j < NCHUNK; ++j) lbar(); return; }
    loadu(0, un);
    lbar();
    for (int j = 0; j < NCHUNK; ++j) {
        {
            const int g = gchunk_of(j);
            const size_t idx = cbase * NCHUNK + g;
            const LAS unsigned char* buf = lds + (j & 1) * P4_BUF;
            const float dec = *(const LAS float*)(buf + P4_DEC);
            f32x16 vn[2];
#pragma unroll
            for (int mt = 0; mt < 2; ++mt) {
                const u32x4 a = un[2 * mt], c2 = un[2 * mt + 1];
                vn[mt][0] = bflo(a.x); vn[mt][1] = bfhi(a.x); vn[mt][2] = bflo(a.y); vn[mt][3] = bfhi(a.y);
                vn[mt][4] = bflo(a.z); vn[mt][5] = bfhi(a.z); vn[mt][6] = bflo(a.w); vn[mt][7] = bfhi(a.w);
                vn[mt][8] = bflo(c2.x); vn[mt][9] = bfhi(c2.x); vn[mt][10] = bflo(c2.y); vn[mt][11] = bfhi(c2.y);
                vn[mt][12] = bflo(c2.z); vn[mt][13] = bfhi(c2.z); vn[mt][14] = bflo(c2.w); vn[mt][15] = bfhi(c2.w);
            }
            if (j + 1 < NCHUNK) loadu(j + 1, un);
            bf16x8 Sb[8];
#pragma unroll
            for (int kk = 0; kk < 8; ++kk) Sb[kk] = packf(S[kk >> 1], kk & 1);
            f32x16 o[2];
#pragma unroll
            for (int i = 0; i < 16; ++i) { o[0][i] = 0.f; o[1][i] = 0.f; }
            bf16x8 vb[4];
            bf16x8 fa[8], fb[8];
            fa[0] = ldsA(buf + P4_W + (32 * 0 + r) * 264 + 8 * hh + 32 * 0);
            fa[1] = ldsA(buf + P4_W + (32 * 1 + r) * 264 + 8 * hh + 32 * 0);
            fa[2] = ldsA(buf + P4_W + (32 * 0 + r) * 264 + 8 * hh + 32 * 1);
            fa[3] = ldsA(buf + P4_W + (32 * 1 + r) * 264 + 8 * hh + 32 * 1);
            fa[4] = ldsA(buf + P4_W + (32 * 0 + r) * 264 + 8 * hh + 32 * 2);
            fa[5] = ldsA(buf + P4_W + (32 * 1 + r) * 264 + 8 * hh + 32 * 2);
            fa[6] = ldsA(buf + P4_W + (32 * 0 + r) * 264 + 8 * hh + 32 * 3);
            fa[7] = ldsA(buf + P4_W + (32 * 1 + r) * 264 + 8 * hh + 32 * 3);
            fb[0] = ldsA(buf + P4_W + (32 * 0 + r) * 264 + 8 * hh + 32 * 4);
            fb[1] = ldsA(buf + P4_W + (32 * 1 + r) * 264 + 8 * hh + 32 * 4);
            fb[2] = ldsA(buf + P4_W + (32 * 0 + r) * 264 + 8 * hh + 32 * 5);
            fb[3] = ldsA(buf + P4_W + (32 * 1 + r) * 264 + 8 * hh + 32 * 5);
            fb[4] = ldsA(buf + P4_W + (32 * 0 + r) * 264 + 8 * hh + 32 * 6);
            fb[5] = ldsA(buf + P4_W + (32 * 1 + r) * 264 + 8 * hh + 32 * 6);
            fb[6] = ldsA(buf + P4_W + (32 * 0 + r) * 264 + 8 * hh + 32 * 7);
            fb[7] = ldsA(buf + P4_W + (32 * 1 + r) * 264 + 8 * hh + 32 * 7);
            __builtin_amdgcn_sched_barrier(0);
            vn[0] = MFMA32(fa[0], Sb[0], vn[0]);
            vn[1] = MFMA32(fa[1], Sb[0], vn[1]);
            vn[0] = MFMA32(fa[2], Sb[1], vn[0]);
            vn[1] = MFMA32(fa[3], Sb[1], vn[1]);
            vn[0] = MFMA32(fa[4], Sb[2], vn[0]);
            vn[1] = MFMA32(fa[5], Sb[2], vn[1]);
            vn[0] = MFMA32(fa[6], Sb[3], vn[0]);
            vn[1] = MFMA32(fa[7], Sb[3], vn[1]);
            __builtin_amdgcn_sched_barrier(0);
            fa[0] = ldsA(buf + P4_QD + (32 * 0 + r) * 264 + 8 * hh + 32 * 0);
            fa[1] = ldsA(buf + P4_QD + (32 * 1 + r) * 264 + 8 * hh + 32 * 0);
            fa[2] = ldsA(buf + P4_QD + (32 * 0 + r) * 264 + 8 * hh + 32 * 1);
            fa[3] = ldsA(buf + P4_QD + (32 * 1 + r) * 264 + 8 * hh + 32 * 1);
            fa[4] = ldsA(buf + P4_QD + (32 * 0 + r) * 264 + 8 * hh + 32 * 2);
            fa[5] = ldsA(buf + P4_QD + (32 * 1 + r) * 264 + 8 * hh + 32 * 2);
            fa[6] = ldsA(buf + P4_QD + (32 * 0 + r) * 264 + 8 * hh + 32 * 3);
            fa[7] = ldsA(buf + P4_QD + (32 * 1 + r) * 264 + 8 * hh + 32 * 3);
            __builtin_amdgcn_sched_barrier(0);
            vn[0] = MFMA32(fb[0], Sb[4], vn[0]);
            vn[1] = MFMA32(fb[1], Sb[4], vn[1]);
            vn[0] = MFMA32(fb[2], Sb[5], vn[0]);
            vn[1] = MFMA32(fb[3], Sb[5], vn[1]);
            vn[0] = MFMA32(fb[4], Sb[6], vn[0]);
            vn[1] = MFMA32(fb[5], Sb[6], vn[1]);
            vn[0] = MFMA32(fb[6], Sb[7], vn[0]);
            vn[1] = MFMA32(fb[7], Sb[7], vn[1]);
            __builtin_amdgcn_sched_barrier(0);
            fb[0] = ldsA(buf + P4_QD + (32 * 0 + r) * 264 + 8 * hh + 32 * 4);
            fb[1] = ldsA(buf + P4_QD + (32 * 1 + r) * 264 + 8 * hh + 32 * 4);
            fb[2] = ldsA(buf + P4_QD + (32 * 0 + r) * 264 + 8 * hh + 32 * 5);
            fb[3] = ldsA(buf + P4_QD + (32 * 1 + r) * 264 + 8 * hh + 32 * 5);
            fb[4] = ldsA(buf + P4_QD + (32 * 0 + r) * 264 + 8 * hh + 32 * 6);
            fb[5] = ldsA(buf + P4_QD + (32 * 1 + r) * 264 + 8 * hh + 32 * 6);
            fb[6] = ldsA(buf + P4_QD + (32 * 0 + r) * 264 + 8 * hh + 32 * 7);
            fb[7] = ldsA(buf + P4_QD + (32 * 1 + r) * 264 + 8 * hh + 32 * 7);
            __builtin_amdgcn_sched_barrier(0);
            o[0] = MFMA32(fa[0], Sb[0], o[0]);
            o[1] = MFMA32(fa[1], Sb[0], o[1]);
            o[0] = MFMA32(fa[2], Sb[1], o[0]);
            o[1] = MFMA32(fa[3], Sb[1], o[1]);
            o[0] = MFMA32(fa[4], Sb[2], o[0]);
            o[1] = MFMA32(fa[5], Sb[2], o[1]);
            o[0] = MFMA32(fa[6], Sb[3], o[0]);
            o[1] = MFMA32(fa[7], Sb[3], o[1]);
            { _Pragma("unroll") for (int q = 0; q < 4; ++q) vb[q] = packf(vn[q >> 1], q & 1); }
            __builtin_amdgcn_sched_barrier(0);
            fa[0] = ldsA(buf + P4_QK + (32 * 0 + r) * 136 + 8 * hh + 32 * 0);
            fa[1] = ldsA(buf + P4_QK + (32 * 1 + r) * 136 + 8 * hh + 32 * 0);
            fa[2] = ldsA(buf + P4_QK + (32 * 0 + r) * 136 + 8 * hh + 32 * 1);
            fa[3] = ldsA(buf + P4_QK + (32 * 1 + r) * 136 + 8 * hh + 32 * 1);
            fa[4] = ldsA(buf + P4_QK + (32 * 0 + r) * 136 + 8 * hh + 32 * 2);
            fa[5] = ldsA(buf + P4_QK + (32 * 1 + r) * 136 + 8 * hh + 32 * 2);
            fa[6] = ldsA(buf + P4_QK + (32 * 0 + r) * 136 + 8 * hh + 32 * 3);
            fa[7] = ldsA(buf + P4_QK + (32 * 1 + r) * 136 + 8 * hh + 32 * 3);
            __builtin_amdgcn_sched_barrier(0);
            o[0] = MFMA32(fb[0], Sb[4], o[0]);
            o[1] = MFMA32(fb[1], Sb[4], o[1]);
            o[0] = MFMA32(fb[2], Sb[5], o[0]);
            o[1] = MFMA32(fb[3], Sb[5], o[1]);
            o[0] = MFMA32(fb[4], Sb[6], o[0]);
            o[1] = MFMA32(fb[5], Sb[6], o[1]);
            o[0] = MFMA32(fb[6], Sb[7], o[0]);
            o[1] = MFMA32(fb[7], Sb[7], o[1]);
            { _Pragma("unroll") for (int ms = 0; ms < 4; ++ms) _Pragma("unroll") for (int i = 0; i < 16; ++i) S[ms][i] *= dec; }
            __builtin_amdgcn_sched_barrier(0);
            fb[0] = ldsA(buf + P4_KDT + (32 * 0 + r) * 136 + 8 * hh + 32 * 0);
            fb[1] = ldsA(buf + P4_KDT + (32 * 1 + r) * 136 + 8 * hh + 32 * 0);
            fb[2] = ldsA(buf + P4_KDT + (32 * 2 + r) * 136 + 8 * hh + 32 * 0);
            fb[3] = ldsA(buf + P4_KDT + (32 * 3 + r) * 136 + 8 * hh + 32 * 0);
            fb[4] = ldsA(buf + P4_KDT + (32 * 0 + r) * 136 + 8 * hh + 32 * 1);
            fb[5] = ldsA(buf + P4_KDT + (32 * 1 + r) * 136 + 8 * hh + 32 * 1);
            fb[6] = ldsA(buf + P4_KDT + (32 * 2 + r) * 136 + 8 * hh + 32 * 1);
            fb[7] = ldsA(buf + P4_KDT + (32 * 3 + r) * 136 + 8 * hh + 32 * 1);
            __builtin_amdgcn_sched_barrier(0);
            o[0] = MFMA32(fa[0], vb[0], o[0]);
            o[1] = MFMA32(fa[1], vb[0], o[1]);
            o[0] = MFMA32(fa[2], vb[1], o[0]);
            o[1] = MFMA32(fa[3], vb[1], o[1]);
            o[0] = MFMA32(fa[4], vb[2], o[0]);
            o[1] = MFMA32(fa[5], vb[2], o[1]);
            o[0] = MFMA32(fa[6], vb[3], o[0]);
            o[1] = MFMA32(fa[7], vb[3], o[1]);
            __builtin_amdgcn_sched_barrier(0);
            fa[0] = ldsA(buf + P4_KDT + (32 * 0 + r) * 136 + 8 * hh + 32 * 2);
            fa[1] = ldsA(buf + P4_KDT + (32 * 1 + r) * 136 + 8 * hh + 32 * 2);
            fa[2] = ldsA(buf + P4_KDT + (32 * 2 + r) * 136 + 8 * hh + 32 * 2);
            fa[3] = ldsA(buf + P4_KDT + (32 * 3 + r) * 136 + 8 * hh + 32 * 2);
            fa[4] = ldsA(buf + P4_KDT + (32 * 0 + r) * 136 + 8 * hh + 32 * 3);
            fa[5] = ldsA(buf + P4_KDT + (32 * 1 + r) * 136 + 8 * hh + 32 * 3);
            fa[6] = ldsA(buf + P4_KDT + (32 * 2 + r) * 136 + 8 * hh + 32 * 3);
            fa[7] = ldsA(buf + P4_KDT + (32 * 3 + r) * 136 + 8 * hh + 32 * 3);
            __builtin_amdgcn_sched_barrier(0);
            S[0] = MFMA32(fb[0], vb[0], S[0]);
            S[1] = MFMA32(fb[1], vb[0], S[1]);
            S[2] = MFMA32(fb[2], vb[0], S[2]);
            S[3] = MFMA32(fb[3], vb[0], S[3]);
            S[0] = MFMA32(fb[4], vb[1], S[0]);
            S[1] = MFMA32(fb[5], vb[1], S[1]);
            S[2] = MFMA32(fb[6], vb[1], S[2]);
            S[3] = MFMA32(fb[7], vb[1], S[3]);
            if (g >= 4 && !dry) {
                bf16_t* op = Ug + idx * 8192 + (size_t)(((2 * dvh + wid) * 2) * 64 + lane) * 16;
#pragma unroll
                for (int mt = 0; mt < 2; ++mt) {
                    u32x4 w0, w1;
                    w0.x = pk2(o[mt][0], o[mt][1]); w0.y = pk2(o[mt][2], o[mt][3]); w0.z = pk2(o[mt][4], o[mt][5]); w0.w = pk2(o[mt][6], o[mt][7]);
                    w1.x = pk2(o[mt][8], o[mt][9]); w1.y = pk2(o[mt][10], o[mt][11]); w1.z = pk2(o[mt][12], o[mt][13]); w1.w = pk2(o[mt][14], o[mt][15]);
                    *(u32x4*)(op + mt * 1024) = w0; *(u32x4*)(op + mt * 1024 + 8) = w1;
                }
            }
            __builtin_amdgcn_sched_barrier(0);
            __builtin_amdgcn_sched_barrier(0);
            S[0] = MFMA32(fa[0], vb[2], S[0]);
            S[1] = MFMA32(fa[1], vb[2], S[1]);
            S[2] = MFMA32(fa[2], vb[2], S[2]);
            S[3] = MFMA32(fa[3], vb[2], S[3]);
            S[0] = MFMA32(fa[4], vb[3], S[0]);
            S[1] = MFMA32(fa[5], vb[3], S[1]);
            S[2] = MFMA32(fa[6], vb[3], S[2]);
            S[3] = MFMA32(fa[7], vb[3], S[3]);
            __builtin_amdgcn_sched_barrier(0);
        }
        lbar();
    }
}

DI void phase_y(const Params& p, LAS unsigned char* lds, const bool dry) {
    const int tid = threadIdx.x;
    unsigned char* ws = p.ws;
    const bf16_t* Ug = (const bf16_t*)(ws + WS_U);
    bf16_t* ZA = (bf16_t*)(ws + WS_Q);
    const float* onw = p.in[11];
    LAS float* Os = (LAS float*)lds;
    const int w = tid >> 7, mt = (tid >> 6) & 1, lane = tid & 63, r = lane & 31, hh = lane >> 5;
    const int tok = tid >> 3, c8 = tid & 7;
    float wn[16];
#pragma unroll
    for (int e = 0; e < 16; ++e) wn[e] = onw[c8 * 16 + e];
    u32x4 fa0, fa1, fb0, fb1, z0, z1;
    auto loaditem = [&](int it) {
        const int b = it >> 9, h = (it >> 6) & 7, n = it & 63;
        const size_t idx0 = (size_t)((b * 8 + h) * 2 + 0) * NCHUNK + 4 + n, idx1 = (size_t)((b * 8 + h) * 2 + 1) * NCHUNK + 4 + n;
        fa0 = *(const u32x4*)(Ug + idx0 * 8192 + (size_t)tid * 16); fa1 = *(const u32x4*)(Ug + idx0 * 8192 + (size_t)tid * 16 + 8);
        fb0 = *(const u32x4*)(Ug + idx1 * 8192 + (size_t)tid * 16); fb1 = *(const u32x4*)(Ug + idx1 * 8192 + (size_t)tid * 16 + 8);
        const bf16_t* zp = ZA + ((size_t)b * 4096 + n * 64 + tok) * 1024 + h * 128 + c8 * 16;
        z0 = *(const u32x4*)zp; z1 = *(const u32x4*)(zp + 8);
    };
    if (blockIdx.x < 4096) loaditem(blockIdx.x);
    for (int it = blockIdx.x; it < 4096; it += gridDim.x) {
        const int b = it >> 9, h = (it >> 6) & 7, n = it & 63;
        const unsigned ua[8] = {fa0.x, fa0.y, fa0.z, fa0.w, fa1.x, fa1.y, fa1.z, fa1.w};
        const unsigned ub[8] = {fb0.x, fb0.y, fb0.z, fb0.w, fb1.x, fb1.y, fb1.z, fb1.w};
        const unsigned zz[8] = {z0.x, z0.y, z0.z, z0.w, z1.x, z1.y, z1.z, z1.w};
        if (it + (int)gridDim.x < 4096) loaditem(it + gridDim.x);
#pragma unroll
        for (int e = 0; e < 8; ++e) {
            Os[(32 * mt + crow(2 * e, hh)) * 129 + 32 * w + r] = bflo(ua[e]);
            Os[(32 * mt + crow(2 * e + 1, hh)) * 129 + 32 * w + r] = bfhi(ua[e]);
        }
        lbar();
#pragma unroll
        for (int e = 0; e < 8; ++e) {
            Os[(63 - (32 * mt + crow(2 * e, hh))) * 129 + 32 * w + r] += bflo(ub[e]);
            Os[(63 - (32 * mt + crow(2 * e + 1, hh))) * 129 + 32 * w + r] += bfhi(ub[e]);
        }
        lbar();
        {
            float o[16]; float ss = 0.f;
#pragma unroll
            for (int e = 0; e < 16; ++e) { o[e] = Os[tok * 129 + c8 * 16 + e]; ss += o[e] * o[e]; }
            ss += __shfl_xor(ss, 1); ss += __shfl_xor(ss, 2); ss += __shfl_xor(ss, 4);
            const float rstd = rsqrtf(ss * (1.f / 128.f) + 1e-6f);
            bf16_t* zp = ZA + ((size_t)b * 4096 + n * 64 + tok) * 1024 + h * 128 + c8 * 16;
            unsigned res[8];
#pragma unroll
            for (int e = 0; e < 8; ++e) {
                const float y0 = o[2 * e] * rstd * wn[2 * e] * bflo(zz[e]);
                const float y1 = o[2 * e + 1] * rstd * wn[2 * e + 1] * bfhi(zz[e]);
                res[e] = pk2(y0, y1);
            }
            u32x4 w0 = {res[0], res[1], res[2], res[3]}, w1 = {res[4], res[5], res[6], res[7]};
            if (!dry) { *(u32x4*)zp = w0; *(u32x4*)(zp + 8) = w1; }
        }
        lbar();
    }
}

DI void phase_final_ln(const Params& p, const bool dry) {
    const int lane = threadIdx.x & 63, wid = threadIdx.x >> 6;
    const float* lg = p.in[17]; const float* lb = p.in[18]; const float* x = p.in[0];
    const float* MOD = (const float*)(p.ws + WS_MOD);
    const bf16_t* Y = (const bf16_t*)(p.ws + WS_Q);
    const int stride = gridDim.x * 8;
    int row = blockIdx.x * 8 + wid;
    f32x4 xv[4], nx[4], gv[4], bv[4]; u32x2 yv[4], ny[4];
#pragma unroll
    for (int i = 0; i < 4; ++i) { gv[i] = *(const f32x4*)(lg + i * 256 + lane * 4); bv[i] = *(const f32x4*)(lb + i * 256 + lane * 4); }
    if (row < XR) {
#pragma unroll
        for (int i = 0; i < 4; ++i) { xv[i] = *(const f32x4*)(x + (size_t)row * 1024 + i * 256 + lane * 4); yv[i] = *(const u32x2*)(Y + (size_t)row * 1024 + i * 256 + lane * 4); }
    }
    for (; row < XR; row += stride) {
        f32x4 gtv[4];
        {
            const float* gate0 = MOD + (row >> 12) * 3072 + 2048;
#pragma unroll
            for (int i = 0; i < 4; ++i) gtv[i] = *(const f32x4*)(gate0 + i * 256 + lane * 4);
        }
        if (row + stride < XR) {
#pragma unroll
            for (int i = 0; i < 4; ++i) { nx[i] = *(const f32x4*)(x + (size_t)(row + stride) * 1024 + i * 256 + lane * 4); ny[i] = *(const u32x2*)(Y + (size_t)(row + stride) * 1024 + i * 256 + lane * 4); }
        }
        const float* gate = MOD + (row >> 12) * 3072 + 2048;
        f32x4 z[4];
#pragma unroll
        for (int i = 0; i < 4; ++i) {
            const f32x4 gt = gtv[i];
            z[i][0] = xv[i][0] * DN_ALPHA + gt[0] * bflo(yv[i].x); z[i][1] = xv[i][1] * DN_ALPHA + gt[1] * bfhi(yv[i].x);
            z[i][2] = xv[i][2] * DN_ALPHA + gt[2] * bflo(yv[i].y); z[i][3] = xv[i][3] * DN_ALPHA + gt[3] * bfhi(yv[i].y);
        }
        float s = 0.f;
#pragma unroll
        for (int i = 0; i < 4; ++i) s += z[i][0] + z[i][1] + z[i][2] + z[i][3];
#pragma unroll
        for (int o = 1; o < 64; o <<= 1) s += __shfl_xor(s, o);
        const float mu = s * (1.f / 1024.f);
        float q = 0.f;
#pragma unroll
        for (int i = 0; i < 4; ++i)
#pragma unroll
            for (int j = 0; j < 4; ++j) { const float dd = z[i][j] - mu; q += dd * dd; }
#pragma unroll
        for (int o = 1; o < 64; o <<= 1) q += __shfl_xor(q, o);
        const float rstd = rsqrtf(q * (1.f / 1024.f) + 1e-5f);
#pragma unroll
        for (int i = 0; i < 4; ++i) {
            f32x4 y;
#pragma unroll
            for (int j = 0; j < 4; ++j) y[j] = (z[i][j] - mu) * rstd * gv[i][j] + bv[i][j];
            if (!dry) *(f32x4*)(p.out + (size_t)row * 1024 + i * 256 + lane * 4) = y;
        }
#pragma unroll
        for (int i = 0; i < 4; ++i) { xv[i] = nx[i]; yv[i] = ny[i]; }
    }
}

__global__ void __launch_bounds__(NTHR, 2) fwd_megakernel(Params p) {
    extern __shared__ __attribute__((aligned(16))) unsigned char smem[];
    LAS unsigned char* lds = (LAS unsigned char*)smem;
    unsigned char* ws = p.ws;
    const int lo = p.ph_lo, hi = p.ph_hi;
#define IN(k) (lo <= (k) && (k) < hi)
#define SEAM(k) do { if (IN(k) && IN((k) + 1)) xcd_barrier(xbar); } while (0)
    if (p.ph_hi == 77) cg::this_grid().sync();
    volatile LAS unsigned* xst = (volatile LAS unsigned*)(lds + SMEM_XB);
    if (threadIdx.x == 0) { xst[0] = 0u; xst[1] = 0u; }
    __syncthreads();
    XcdBarrier xbar; xbar.bar = (unsigned*)(ws + WS_BAR); xbar.x = 0; xbar.st = xst;
    if (hi - lo > 1) xbar = xcd_barrier_post((unsigned*)(ws + WS_BAR), xst);
    const bool dryrt = (p.ph_hi != 77);
    const float* BP = (const float*)(ws + WS_BIASP);
    if (PROBE_DUP == 0 && IN(0)) { phase0(p, lds); xcd_barrier(xbar); }
    if (IN(0)) phase0(p, lds);
    SEAM(0);
    if (PROBE_DUP == 1 && IN(1)) { phase_ln_mod(p); xcd_barrier(xbar); }
    if (IN(1)) phase_ln_mod(p);
    SEAM(1);
    for (int rep = (PROBE_DUP == 2 ? 0 : 1); rep < 2; ++rep) { if (rep == 0) { } else if (PROBE_DUP == 2) xcd_barrier(xbar);
    if (IN(2)) {
        pg8::Gemm g{(const bf16_t*)(ws + WS_QKHX), (const bf16_t*)(ws + WS_WINT), ROWS, 13 * 256, 1024};
        pg8::StaticOrder S; S.init(ROWS, 13 * 256, gridDim.x, blockIdx.x);
        static_assert(WS_V - WS_K == WS_K - WS_Q, "q|k|v buffers equally spaced");
        EpiQKV E{(bf16_t*)(ws + WS_Q), (float*)(ws + WS_AB), BP};
        pg8::gemm_phase(lds, g, S, E);
    }
    }
    SEAM(2);
    if (PROBE_DUP == 3 && IN(3)) { phase_gdn_pre(p, lds, dryrt); xcd_barrier(xbar); }
    if (IN(3)) phase_gdn_pre(p, lds, false);
    SEAM(3);
    if (PROBE_DUP == 4 && IN(4)) { phase_gdn_scan(p, lds, dryrt); xcd_barrier(xbar); }
    if (IN(4)) phase_gdn_scan(p, lds, false);
    SEAM(4);
    for (int rep = (PROBE_DUP == 6 ? 0 : 1); rep < 2; ++rep) { if (rep == 0) { } else if (PROBE_DUP == 6) xcd_barrier(xbar);
    if (IN(6)) {
        pg8::Gemm g{(const bf16_t*)(ws + WS_QKHX), (const bf16_t*)(ws + WS_WINT) + (size_t)13 * 256 * 1024, XR, 28 * 256, 1024};
        pg8::StaticOrder S; S.init(XR, 28 * 256, gridDim.x, blockIdx.x);
        EpiRest E{(bf16_t*)(ws + WS_Q), (bf16_t*)(ws + WS_V), (bf16_t*)p.out, (bf16_t*)p.out + (size_t)XR * 1024, BP + 13 * 256, p.in[12], p.in[13]};
        pg8::gemm_phase(lds, g, S, E);
    }
    }
    SEAM(6);
    if (PROBE_DUP == 7 && IN(7)) { phase_y(p, lds, dryrt); xcd_barrier(xbar); }
    if (IN(7)) phase_y(p, lds, false);
    SEAM(7);
    for (int rep = (PROBE_DUP == 8 ? 0 : 1); rep < 2; ++rep) { if (rep == 0) { } else if (PROBE_DUP == 8) xcd_barrier(xbar);
    if (IN(8)) {
        static_assert(WS_V - WS_Q == (size_t)EpiMergePair::DPM * 256 * 1024 * 2 && WS_WBT - WS_WAT == (size_t)EpiMergePair::DPN * 256 * 1024 * 2, "pair offsets");
        pg8::PairOrder S; S.S.init(XR, 1024, gridDim.x, blockIdx.x); S.dpm = EpiMergePair::DPM; S.dpn = EpiMergePair::DPN;
        pg8::Gemm g{(const bf16_t*)(ws + WS_Q), (const bf16_t*)(ws + WS_WAT), XR, 1024, 1024};
        EpiMergePair E{(bf16_t*)(ws + WS_QKHX), (const bf16_t*)p.out, (const bf16_t*)p.out + (size_t)XR * 1024};
        pg8::gemm_phase(lds, g, S, E);
    }
    }
    SEAM(8);
    for (int rep = (PROBE_DUP == 9 ? 0 : 1); rep < 2; ++rep) { if (rep == 0) { } else if (PROBE_DUP == 9) xcd_barrier(xbar);
    if (IN(9)) {
        pg8::Gemm g{(const bf16_t*)(ws + WS_QKHX), (const bf16_t*)(ws + WS_WOT), XR, 1024, 1024};
        pg8::StaticOrder S; S.init(XR, 1024, gridDim.x, blockIdx.x);
        EpiOut E{(bf16_t*)(ws + WS_Q)};
        pg8::gemm_phase(lds, g, S, E);
    }
    }
    SEAM(9);
    if (PROBE_DUP == 10 && IN(10)) { phase_final_ln(p, dryrt); xcd_barrier(xbar); }
    if (IN(10)) phase_final_ln(p, false);
#undef IN
#undef SEAM
}

constexpr int N_PHASES = 11;

extern "C" void kernel_launch(void* const* d_in, const int* in_sizes, int n_in, void* d_out, int out_size, void* d_ws, size_t ws_size, hipStream_t stream) {
    static int grid = 0;
    if (grid == 0) {
        if (n_in != 19 || out_size != XR * DM || ws_size < WS_END) { fprintf(stderr, "kernel_launch: unexpected shapes / workspace (%d inputs, out %d, ws %zu < %zu)\n", n_in, out_size, ws_size, (size_t)WS_END); grid = -1; return; }
        int dev = 0, cus = 0, per_cu = 0;
        hipGetDevice(&dev);
        hipDeviceGetAttribute(&cus, hipDeviceAttributeMultiprocessorCount, dev);
        if (hipFuncSetAttribute((const void*)fwd_megakernel, hipFuncAttributeMaxDynamicSharedMemorySize, SMEM_BYTES) != hipSuccess) { fprintf(stderr, "kernel_launch: hipFuncSetAttribute failed\n"); grid = -1; return; }
        hipOccupancyMaxActiveBlocksPerMultiprocessor(&per_cu, (const void*)fwd_megakernel, NTHR, SMEM_BYTES);
        if (per_cu < 1) per_cu = 1;
        grid = cus * per_cu;
        if (grid > 256) grid = 256;
        (void)hipGetLastError();
    }
    if (grid < 0) return;
    if (hipMemsetAsync((char*)d_ws + WS_BAR, 0, (size_t)XCD_BAR_WORDS_C * 4, stream) != hipSuccess) { fprintf(stderr, "kernel_launch: memset of barrier words failed\n"); return; }
    Params p{};
    for (int i = 0; i < 19; ++i) p.in[i] = (const float*)d_in[i];
    p.out = (float*)d_out; p.ws = (unsigned char*)d_ws;
#if MK_MULTI
    for (int k = 0; k < N_PHASES; ++k) {
        p.ph_lo = k; p.ph_hi = k + 1;
        hipLaunchKernelGGL(fwd_megakernel, dim3(grid), dim3(NTHR), SMEM_BYTES, stream, p);
    }
#else
    p.ph_lo = 0; p.ph_hi = N_PHASES;
    void* args[] = {&p};
    hipError_t e = hipLaunchCooperativeKernel((const void*)fwd_megakernel, dim3(grid), dim3(NTHR), args, SMEM_BYTES, stream);
    if (e != hipSuccess) fprintf(stderr, "cooperative launch failed: %s (grid %d)\n", hipGetErrorString(e), grid);
#endif
}
```
